# Optimizing an MI355X kernel written in HIP

```python
import jax, jax.numpy as jnp
from jax import lax
import numpy as np

D_MODEL = 1024
BATCH = 8
SEQ = 2048
DEPTH = 1

CHUNK = 64
A_WIDTH = D_MODEL // 2
A_HEAD = 64
A_HEADS = A_WIDTH // A_HEAD
D_DECAY_LORA = 64
D_AAA_LORA = 64
D_GATE_LORA = 160
LNX_EPS = 64e-5
B_WIDTH = D_MODEL // 2
B_GROUPS = 4
B_GROUP_CH = B_WIDTH // B_GROUPS
GMLP_BLOCK = 2 * CHUNK
LN_EPS = 1e-5
A_COLS = 3 * A_WIDTH + D_DECAY_LORA + D_AAA_LORA + D_GATE_LORA
B_COLS = 2 * B_WIDTH
GATE_COLS = 2 * D_MODEL
IN_COLS = A_COLS + B_COLS + GATE_COLS
N_GROUPS = 4
EXPERTS_PER_GROUP = 8
N_EXPERTS = N_GROUPS * EXPERTS_PER_GROUP
TOP_K_IN_GROUP = 2
D_EXPERT = 256
NORM_EPS = 1e-6

kernel_name = "hybrid_rwkv7_gmlp_hmoe_block"


def rms_norm(x, g):
    xf = x.astype(jnp.float32)
    y = xf * lax.rsqrt(jnp.mean(xf * xf, axis=-1, keepdims=True) + NORM_EPS)
    return (y * g.astype(jnp.float32)).astype(x.dtype)


def token_shift(p):
    return jnp.pad(p, ((0, 0), (1, 0), (0, 0)))[:, :-1]


def wkv7(r, dec, k, v, a, b):
    bsz, _, nh, n = r.shape

    def step(S, inp):
        r_t, d_t, k_t, v_t, a_t, b_t = inp
        sa = jnp.einsum('bhij,bhj->bhi', S, a_t)
        S = (S * d_t[:, :, None, :]
             + sa[..., :, None] * b_t[..., None, :]
             + v_t[..., :, None] * k_t[..., None, :])
        return S, jnp.einsum('bhij,bhj->bhi', S, r_t)

    xs = (jnp.moveaxis(r, 1, 0), jnp.moveaxis(dec, 1, 0), jnp.moveaxis(k, 1, 0),
          jnp.moveaxis(v, 1, 0), jnp.moveaxis(a, 1, 0), jnp.moveaxis(b, 1, 0))
    S0 = jnp.zeros((bsz, nh, n, n), jnp.float32)
    _, ys = lax.scan(step, S0, xs)
    return jnp.moveaxis(ys, 0, 1)


def rwkv7_branch(p, mu, w0, w2, a0, a2, g2, k_k, k_a, r_k, lnx_g, lnx_b, w_o):
    bsz, t, _ = p.shape
    pf = p.astype(jnp.float32)
    pm = pf + mu * (token_shift(pf) - pf)
    s0 = A_WIDTH
    s1 = 2 * A_WIDTH
    s2 = 3 * A_WIDTH
    s3 = s2 + D_DECAY_LORA
    s4 = s3 + D_AAA_LORA
    r, k, v, xw, xa, xg = jnp.split(pm, [s0, s1, s2, s3, s4], axis=-1)
    w = -jax.nn.softplus(-(w0 + jnp.tanh(xw) @ w2)) - 0.5
    a = jax.nn.sigmoid(a0 + xa @ a2)
    g = jax.nn.sigmoid(xg) @ g2
    hs = (bsz, t, A_HEADS, A_HEAD)
    kk = (k * k_k).reshape(hs)
    kk = kk / jnp.maximum(jnp.sqrt(jnp.sum(kk * kk, axis=-1, keepdims=True)), 1e-12)
    k = k * (1.0 + (a - 1.0) * k_a)
    r_h = r.reshape(hs)
    k_h = k.reshape(hs)
    v_h = v.reshape(hs)
    a_h = a.reshape(hs)
    dec = jnp.exp(-jnp.exp(w)).reshape(hs)
    y = wkv7(r_h, dec, k_h, v_h, -kk, kk * a_h)
    mean = jnp.mean(y, axis=-1, keepdims=True)
    var = jnp.mean(jnp.square(y - mean), axis=-1, keepdims=True)
    y = ((y - mean) * lax.rsqrt(var + LNX_EPS)).reshape(bsz, t, A_WIDTH) * lnx_g + lnx_b
    bonus = jnp.sum(r_h * k_h * r_k, axis=-1, keepdims=True) * v_h
    y = y + bonus.reshape(bsz, t, A_WIDTH)
    return ((y * g).astype(p.dtype)) @ w_o


def gmlp_branch(p, lnv_g, lnv_b, w_s, b_s, w_o):
    bsz, t, _ = p.shape
    z = jax.nn.gelu(p, approximate=False)
    u, v = jnp.split(z, 2, axis=-1)
    vf = v.astype(jnp.float32)
    mean = jnp.mean(vf, axis=-1, keepdims=True)
    var = jnp.mean(jnp.square(vf - mean), axis=-1, keepdims=True)
    vf = (vf - mean) * lax.rsqrt(var + LN_EPS) * lnv_g + lnv_b
    vb = vf.reshape(bsz, t // GMLP_BLOCK, GMLP_BLOCK, B_GROUPS, B_GROUP_CH)
    mask = jnp.tril(jnp.ones((GMLP_BLOCK, GMLP_BLOCK), dtype=bool))
    ws = jnp.where(mask[None], w_s, jnp.zeros_like(w_s)).astype(jnp.float32)
    sv = jnp.einsum('gts,bcsgd->bctgd', ws, vb) + b_s.T.astype(jnp.float32)[:, :, None]
    sv = sv.reshape(bsz, t, B_WIDTH).astype(u.dtype)
    return (u * sv) @ w_o


def hier_moe(h, w_rg, b_rg, w_re, b_re, w_gate, w_up, w_down):
    bsz, t, d = h.shape
    hf = h.reshape(bsz * t, d)
    n_tok = bsz * t
    g_prob = jax.nn.softmax((hf @ w_rg + b_rg).astype(jnp.float32), axis=-1)
    g_p, g_idx = lax.top_k(g_prob, 1)
    e_logits = (jnp.einsum('nd,gde->nge', hf, w_re) + b_re).astype(jnp.float32)
    e_sel = jnp.take_along_axis(e_logits, g_idx[:, :, None], axis=1)[:, 0]
    e_val, e_idx = lax.top_k(e_sel, TOP_K_IN_GROUP)
    e_w = jax.nn.softmax(e_val, axis=-1) * g_p
    w_grp = jnp.sum(jax.nn.one_hot(e_idx, EXPERTS_PER_GROUP, dtype=jnp.float32) * e_w[..., None], axis=1)
    combine = (jax.nn.one_hot(g_idx[:, 0], N_GROUPS, dtype=jnp.float32)[:, :, None]
               * w_grp[:, None, :]).reshape(n_tok, N_EXPERTS).astype(h.dtype)
    y = jnp.zeros_like(hf)
    for e in range(N_EXPERTS):
        act = jax.nn.silu(hf @ w_gate[e]) * (hf @ w_up[e])
        y = y + combine[:, e:e + 1] * (act @ w_down[e])
    return y.reshape(bsz, t, d)


def setup_inputs(seed: int = 0) -> dict:
    key = jax.random.key(seed)
    ks = jax.random.split(key, 32)
    L = DEPTH

    def nrm(k, shape, scale):
        return jax.random.normal(k, shape, jnp.float32) * scale

    return {
        "x": nrm(ks[0], (BATCH, SEQ, D_MODEL), 1.0),
        "norm1_g": 1.0 + nrm(ks[1], (L, D_MODEL), 0.02),
        "w_in": nrm(ks[2], (L, D_MODEL, IN_COLS), D_MODEL ** -0.5),
        "b_gate": nrm(ks[3], (L, GATE_COLS), 0.02),
        "tmix_mu": jax.random.uniform(ks[4], (L, A_COLS), jnp.float32),
        "w0": jax.random.uniform(ks[5], (L, A_WIDTH), jnp.float32, minval=-6.0, maxval=1.0),
        "w2": nrm(ks[6], (L, D_DECAY_LORA, A_WIDTH), 0.1 * D_DECAY_LORA ** -0.5),
        "a0": nrm(ks[7], (L, A_WIDTH), 0.1),
        "a2": nrm(ks[8], (L, D_AAA_LORA, A_WIDTH), 0.1 * D_AAA_LORA ** -0.5),
        "g2": nrm(ks[9], (L, D_GATE_LORA, A_WIDTH), D_GATE_LORA ** -0.5),
        "k_k": 0.85 + nrm(ks[10], (L, A_WIDTH), 0.02),
        "k_a": 1.0 + nrm(ks[11], (L, A_WIDTH), 0.02),
        "r_k": nrm(ks[12], (L, A_HEADS, A_HEAD), 0.1),
        "lnx_g": 1.0 + nrm(ks[13], (L, A_WIDTH), 0.02),
        "lnx_b": nrm(ks[14], (L, A_WIDTH), 0.02),
        "w_oA": nrm(ks[15], (L, A_WIDTH, D_MODEL), A_WIDTH ** -0.5),
        "lnv_g": 1.0 + nrm(ks[16], (L, B_WIDTH), 0.02),
        "lnv_b": nrm(ks[17], (L, B_WIDTH), 0.02),
        "w_s": nrm(ks[18], (L, B_GROUPS, GMLP_BLOCK, GMLP_BLOCK), GMLP_BLOCK ** -0.5),
        "b_s": 1.0 + nrm(ks[19], (L, B_GROUPS, GMLP_BLOCK), 0.02),
        "w_oB": nrm(ks[20], (L, B_WIDTH, D_MODEL), B_WIDTH ** -0.5),
        "w_out": nrm(ks[21], (L, D_MODEL, D_MODEL), D_MODEL ** -0.5),
        "norm2_g": 1.0 + nrm(ks[22], (L, D_MODEL), 0.02),
        "w_rg": nrm(ks[23], (L, D_MODEL, N_GROUPS), D_MODEL ** -0.5),
        "b_rg": nrm(ks[24], (L, N_GROUPS), 0.01),
        "w_re": nrm(ks[25], (L, N_GROUPS, D_MODEL, EXPERTS_PER_GROUP), D_MODEL ** -0.5),
        "b_re": nrm(ks[26], (L, N_GROUPS, EXPERTS_PER_GROUP), 0.01),
        "w_e_gate": nrm(ks[27], (L, N_EXPERTS, D_MODEL, D_EXPERT), D_MODEL ** -0.5),
        "w_e_up": nrm(ks[28], (L, N_EXPERTS, D_MODEL, D_EXPERT), D_MODEL ** -0.5),
        "w_e_down": nrm(ks[29], (L, N_EXPERTS, D_EXPERT, D_MODEL), D_EXPERT ** -0.5),
        "final_g": 1.0 + nrm(ks[30], (D_MODEL,), 0.02),
    }


def reference(x, norm1_g, w_in, b_gate, tmix_mu, w0, w2, a0, a2, g2, k_k, k_a, r_k,
              lnx_g, lnx_b, w_oA, lnv_g, lnv_b, w_s, b_s, w_oB, w_out, norm2_g,
              w_rg, b_rg, w_re, b_re, w_e_gate, w_e_up, w_e_down, final_g):
    for l in range(DEPTH):
        h = rms_norm(x, norm1_g[l])
        p = h @ w_in[l]
        p_a = p[..., :A_COLS]
        p_b = p[..., A_COLS:A_COLS + B_COLS]
        p_g = p[..., A_COLS + B_COLS:]
        y_a = rwkv7_branch(p_a, tmix_mu[l], w0[l], w2[l], a0[l], a2[l], g2[l], k_k[l], k_a[l],
                           r_k[l], lnx_g[l], lnx_b[l], w_oA[l])
        y_b = gmlp_branch(p_b, lnv_g[l], lnv_b[l], w_s[l], b_s[l], w_oB[l])
        gates = jax.nn.sigmoid(p_g + b_gate[l])
        g_a, g_b = jnp.split(gates, 2, axis=-1)
        x = x + (g_a * y_a + g_b * y_b) @ w_out[l]
        x = x + hier_moe(rms_norm(x, norm2_g[l]), w_rg[l], b_rg[l], w_re[l], b_re[l],
                         w_e_gate[l], w_e_up[l], w_e_down[l])
    return rms_norm(x, final_g)
```

```cpp
#include <hip/hip_runtime.h>
#include <stdint.h>
#include <math.h>

namespace {
typedef unsigned short bf16;
constexpr int D = 1024, BATCH = 8, T = 2048, M = BATCH * T;
constexpr int AW = 512;
constexpr int A_COLS = 1824, B_COLS = 1024, IN_COLS = 4896;
constexpr int PA_LD = 2048;
constexpr size_t MiB = 1u << 20;
constexpr size_t WS_PA = 16 * MiB, WS_ZB = 80 * MiB, WS_GT = 112 * MiB, WS_LW = 176 * MiB, WS_VV = 192 * MiB, WS_GG = 208 * MiB,
                 WS_YB = 224 * MiB, WS_YA = 240 * MiB, WS_Y = 16 * MiB  , WS_MIX = 48 * MiB, WS_H2 = 80 * MiB, WS_SEL = 1 * MiB;

__device__ __forceinline__ float bf2f(bf16 b) { return __uint_as_float(((unsigned)b) << 16); }
__device__ __forceinline__ bf16 f2bf(float f) { unsigned u = __float_as_uint(f); u += 0x7fffu + ((u >> 16) & 1u); return (bf16)(u >> 16); }
__device__ __forceinline__ float wave_sum(float v) {
#pragma unroll
    for (int o = 1; o < 64; o <<= 1) v += __shfl_xor(v, o);
    return v;
}
__device__ __forceinline__ float sigmoidf_(float x) { return 1.f / (1.f + expf(-x)); }

__global__ void __launch_bounds__(256) k_rms_bf16(const float* __restrict__ x, const float* __restrict__ g, bf16* __restrict__ out) {
    const int row = blockIdx.x * 4 + (threadIdx.x >> 6), lane = threadIdx.x & 63;
    const float4* xr = (const float4*)(x + (size_t)row * D) + lane;
    float4 v[4]; float s = 0.f;
#pragma unroll
    for (int j = 0; j < 4; ++j) { v[j] = xr[64 * j]; s += v[j].x * v[j].x + v[j].y * v[j].y + v[j].z * v[j].z + v[j].w * v[j].w; }
    s = wave_sum(s);
    const float rs = rsqrtf(s * (1.f / D) + 1e-6f);
#pragma unroll
    for (int j = 0; j < 4; ++j) { const int c = 4 * lane + 256 * j; bf16* o = out + (size_t)row * D + c;
        o[0] = f2bf(v[j].x * rs * g[c]); o[1] = f2bf(v[j].y * rs * g[c + 1]); o[2] = f2bf(v[j].z * rs * g[c + 2]); o[3] = f2bf(v[j].w * rs * g[c + 3]); }
}

__device__ __forceinline__ void ngemm_acc(const bf16* __restrict__ A, int lda, const float* __restrict__ W, int ldw, int K, int m0, int n, bool nok, float (&acc)[8], float* As) {
    __syncthreads();
    for (int idx = threadIdx.x; idx < 8 * K; idx += 256) { const int i = idx / K, k = idx - i * K; As[i * 1024 + k] = bf2f(A[(size_t)(m0 + i) * lda + k]); }
    __syncthreads();
    if (nok) {
        for (int k = 0; k < K; ++k) { const float w = W[(size_t)k * ldw + n];
#pragma unroll
            for (int i = 0; i < 8; ++i) acc[i] += As[i * 1024 + k] * w; }
    }
}

__global__ void __launch_bounds__(256) k_gemm1(const bf16* __restrict__ H1, const float* __restrict__ w_in, const float* __restrict__ b_gate, bf16* PA, bf16* ZB, bf16* GT) {
    __shared__ float As[8 * 1024];
    const int n = blockIdx.x * 256 + threadIdx.x, m0 = blockIdx.y * 8; const bool nok = n < IN_COLS;
    float acc[8] = {0, 0, 0, 0, 0, 0, 0, 0};
    ngemm_acc(H1, D, w_in, IN_COLS, D, m0, n, nok, acc, As);
    if (!nok) return;
#pragma unroll
    for (int i = 0; i < 8; ++i) { const size_t m = m0 + i; const float p = acc[i];
        if (n < A_COLS) PA[m * PA_LD + n] = f2bf(p);
        else if (n < A_COLS + B_COLS) ZB[m * 1024 + (n - A_COLS)] = f2bf(0.5f * p * (1.f + erff(p * 0.70710678118f)));
        else { const int c = n - A_COLS - B_COLS; GT[m * 2048 + c] = f2bf(sigmoidf_(p + b_gate[c])); } }
}

__global__ void __launch_bounds__(512) k_prep(const bf16* __restrict__ PA, const float* __restrict__ mu, const float* __restrict__ w0, const float* __restrict__ w2, const float* __restrict__ a0,
                                              const float* __restrict__ a2, const float* __restrict__ g2, const float* __restrict__ k_k, const float* __restrict__ k_a,
                                              bf16* R, bf16* KK, bf16* BV, bf16* KM, bf16* LW, bf16* VV, bf16* GG) {
    __shared__ float xs[288];
    const int m = blockIdx.x, t = m & (T - 1), c = threadIdx.x;
    const bf16* p = PA + (size_t)m * PA_LD; const bf16* pp = p - PA_LD;
    auto lerp = [&](int col) { const float cur = bf2f(p[col]); const float prev = t > 0 ? bf2f(pp[col]) : 0.f; return cur + mu[col] * (prev - cur); };
    const float r = lerp(c), k = lerp(512 + c), v = lerp(1024 + c);
    if (c < 288) { float xv = lerp(1536 + c); if (c < 64) xv = tanhf(xv); else if (c >= 128) xv = sigmoidf_(xv); xs[c] = xv; }
    __syncthreads();
    float wp = w0[c], ap = a0[c], gp = 0.f;
#pragma unroll 8
    for (int q = 0; q < 64; ++q) { wp += xs[q] * w2[q * 512 + c]; ap += xs[64 + q] * a2[q * 512 + c]; }
#pragma unroll 8
    for (int q = 0; q < 160; ++q) gp += xs[128 + q] * g2[q * 512 + c];
    const float lw = -0.60653066f * sigmoidf_(wp);
    const float a = sigmoidf_(ap);
    float kk = k * k_k[c];
    const float ss = wave_sum(kk * kk);
    kk = kk / fmaxf(sqrtf(ss), 1e-12f);
    const float km = k * (1.f + (a - 1.f) * k_a[c]);
    const size_t o = (size_t)m * AW + c;
    R[o] = f2bf(r); KK[o] = f2bf(kk); BV[o] = f2bf(kk * a); KM[o] = f2bf(km); LW[o] = f2bf(lw); VV[o] = f2bf(v); GG[o] = f2bf(gp);
}

__global__ void __launch_bounds__(256) k_gmlp(const bf16* __restrict__ ZB, const float* __restrict__ lnv_g, const float* __restrict__ lnv_b, const float* __restrict__ w_s, const float* __restrict__ b_s, bf16* YB) {
    __shared__ float vn[128][64];
    __shared__ float s_mean[128], s_rstd[128];
    const int dh = blockIdx.x & 1, g = (blockIdx.x >> 1) & 3, bc = blockIdx.x >> 3;
    const int wave = threadIdx.x >> 6, lane = threadIdx.x & 63; const size_t m0 = (size_t)bc * 128;
    for (int s = wave * 32; s < wave * 32 + 32; ++s) { const bf16* vr = ZB + (m0 + s) * 1024 + 512;
        float x[8]; float sum = 0.f;
#pragma unroll
        for (int j = 0; j < 8; ++j) { x[j] = bf2f(vr[lane + 64 * j]); sum += x[j]; }
        const float mean = wave_sum(sum) * (1.f / 512.f); float q = 0.f;
#pragma unroll
        for (int j = 0; j < 8; ++j) { const float d = x[j] - mean; q += d * d; }
        const float var = wave_sum(q) * (1.f / 512.f);
        if (lane == 0) { s_mean[s] = mean; s_rstd[s] = rsqrtf(var + 1e-5f); } }
    __syncthreads();
    const int ch0 = g * 128 + dh * 64;
    for (int idx = threadIdx.x; idx < 128 * 64; idx += 256) { const int s = idx >> 6, dd = idx & 63; const int ch = ch0 + dd;
        vn[s][dd] = (bf2f(ZB[(m0 + s) * 1024 + 512 + ch]) - s_mean[s]) * s_rstd[s] * lnv_g[ch] + lnv_b[ch]; }
    __syncthreads();
    const int dd = threadIdx.x & 63, tq = threadIdx.x >> 6;
    for (int t = tq * 32; t < tq * 32 + 32; ++t) { const float* wr = w_s + ((size_t)g * 128 + t) * 128; float acc = 0.f;
        for (int s = 0; s <= t; ++s) acc += wr[s] * vn[s][dd];
        const float sv = acc + b_s[g * 128 + t]; const size_t m = m0 + t; const float u = bf2f(ZB[m * 1024 + ch0 + dd]);
        YB[m * AW + ch0 + dd] = f2bf(u * sv); }
}

__global__ void __launch_bounds__(64) k_wkv_naive(const bf16* __restrict__ R, const bf16* __restrict__ KK, const bf16* __restrict__ BV, const bf16* __restrict__ KM, const bf16* __restrict__ LW,
                                                  const bf16* __restrict__ VV, float* Y) {
    __shared__ float va[64], vb[64], vk[64], vr[64], vd[64];
    const int b = blockIdx.x >> 3, h = blockIdx.x & 7, lane = threadIdx.x;
    float s[64];
#pragma unroll
    for (int j = 0; j < 64; ++j) s[j] = 0.f;
    for (int t = 0; t < T; ++t) { const size_t o = ((size_t)b * T + t) * AW + h * 64 + lane;
        va[lane] = -bf2f(KK[o]); vb[lane] = bf2f(BV[o]); vk[lane] = bf2f(KM[o]); vr[lane] = bf2f(R[o]); vd[lane] = expf(bf2f(LW[o]));
        const float v = bf2f(VV[o]);
        __syncthreads();
        float sa = 0.f;
#pragma unroll
        for (int j = 0; j < 64; ++j) sa += s[j] * va[j];
        float y = 0.f;
#pragma unroll
        for (int j = 0; j < 64; ++j) { s[j] = s[j] * vd[j] + sa * vb[j] + v * vk[j]; y += s[j] * vr[j]; }
        Y[o] = y;
        __syncthreads(); }
}

__global__ void __launch_bounds__(512) k_post(const float* __restrict__ Y, const bf16* __restrict__ R, const bf16* __restrict__ KM, const bf16* __restrict__ VV, const bf16* __restrict__ GG,
                                              const float* __restrict__ r_k, const float* __restrict__ lnx_g, const float* __restrict__ lnx_b, bf16* YA) {
    const int c = threadIdx.x; const size_t o = (size_t)blockIdx.x * AW + c;
    const float y = Y[o]; const float mean = wave_sum(y) * (1.f / 64.f); const float d = y - mean; const float var = wave_sum(d * d) * (1.f / 64.f);
    const float yn = d * rsqrtf(var + 64e-5f) * lnx_g[c] + lnx_b[c];
    const float r = bf2f(R[o]), km = bf2f(KM[o]), v = bf2f(VV[o]), g = bf2f(GG[o]);
    const float bonus = wave_sum(r * km * r_k[c]) * v;
    YA[o] = f2bf((yn + bonus) * g);
}

__global__ void __launch_bounds__(256) k_mix(const bf16* __restrict__ YA, const bf16* __restrict__ YB, const bf16* __restrict__ GT, const float* __restrict__ w_oA, const float* __restrict__ w_oB, bf16* MIX) {
    __shared__ float As[8 * 1024];
    const int n = blockIdx.x * 256 + threadIdx.x, m0 = blockIdx.y * 8;
    float a1[8] = {0, 0, 0, 0, 0, 0, 0, 0}, a2[8] = {0, 0, 0, 0, 0, 0, 0, 0};
    ngemm_acc(YA, AW, w_oA, D, AW, m0, n, true, a1, As);
    ngemm_acc(YB, AW, w_oB, D, AW, m0, n, true, a2, As);
#pragma unroll
    for (int i = 0; i < 8; ++i) { const size_t m = m0 + i; MIX[m * D + n] = f2bf(bf2f(GT[m * 2048 + n]) * a1[i] + bf2f(GT[m * 2048 + 1024 + n]) * a2[i]); }
}
__global__ void __launch_bounds__(256) k_wout(const bf16* __restrict__ MIX, const float* __restrict__ w_out, const float* __restrict__ x, float* X1) {
    __shared__ float As[8 * 1024];
    const int n = blockIdx.x * 256 + threadIdx.x, m0 = blockIdx.y * 8;
    float acc[8] = {0, 0, 0, 0, 0, 0, 0, 0};
    ngemm_acc(MIX, D, w_out, D, D, m0, n, true, acc, As);
#pragma unroll
    for (int i = 0; i < 8; ++i) { const size_t m = m0 + i; X1[m * D + n] = x[m * D + n] + acc[i]; }
}

__global__ void __launch_bounds__(256) k_router(const float* __restrict__ X1, const float* __restrict__ g2n, const float* __restrict__ w_rg, const float* __restrict__ b_rg, const float* __restrict__ w_re,
                                                const float* __restrict__ b_re, bf16* H2, int2* SEL_E, float2* SEL_W) {
    const int m = blockIdx.x * 4 + (threadIdx.x >> 6), lane = threadIdx.x & 63;
    const float4* xr = (const float4*)(X1 + (size_t)m * D) + lane;
    float h[16]; float s = 0.f;
#pragma unroll
    for (int j = 0; j < 4; ++j) { const float4 v = xr[64 * j]; h[4 * j] = v.x; h[4 * j + 1] = v.y; h[4 * j + 2] = v.z; h[4 * j + 3] = v.w; s += v.x * v.x + v.y * v.y + v.z * v.z + v.w * v.w; }
    const float rs = rsqrtf(wave_sum(s) * (1.f / D) + 1e-6f);
#pragma unroll
    for (int j = 0; j < 4; ++j)
#pragma unroll
        for (int i = 0; i < 4; ++i) { const int c = 4 * lane + 256 * j + i; h[4 * j + i] *= rs * g2n[c]; H2[(size_t)m * D + c] = f2bf(h[4 * j + i]); }
    float gl[4];
#pragma unroll
    for (int gi = 0; gi < 4; ++gi) { float p = 0.f;
#pragma unroll
        for (int j = 0; j < 4; ++j)
#pragma unroll
            for (int i = 0; i < 4; ++i) { const int c = 4 * lane + 256 * j + i; p += h[4 * j + i] * w_rg[c * 4 + gi]; }
        gl[gi] = wave_sum(p) + b_rg[gi]; }
    int gs = 0; float gm = gl[0];
#pragma unroll
    for (int gi = 1; gi < 4; ++gi) if (gl[gi] > gm) { gm = gl[gi]; gs = gi; }
    float den = 0.f;
#pragma unroll
    for (int gi = 0; gi < 4; ++gi) den += expf(gl[gi] - gm);
    const float gp = 1.f / den;
    float el[8];
#pragma unroll
    for (int e = 0; e < 8; ++e) { float p = 0.f;
#pragma unroll
        for (int j = 0; j < 4; ++j)
#pragma unroll
            for (int i = 0; i < 4; ++i) { const int c = 4 * lane + 256 * j + i; p += h[4 * j + i] * w_re[((size_t)gs * D + c) * 8 + e]; }
        el[e] = wave_sum(p) + b_re[gs * 8 + e]; }
    int i1 = 0; float m1 = el[0];
#pragma unroll
    for (int e = 1; e < 8; ++e) if (el[e] > m1) { m1 = el[e]; i1 = e; }
    int i2 = -1; float m2 = -INFINITY;
#pragma unroll
    for (int e = 0; e < 8; ++e) if (e != i1 && el[e] > m2) { m2 = el[e]; i2 = e; }
    const float w1 = 1.f / (1.f + expf(m2 - m1)), w2 = 1.f - w1;
    if (lane == 0) { SEL_E[m] = make_int2(gs * 8 + i1, gs * 8 + i2); SEL_W[m] = make_float2(w1 * gp, w2 * gp); }
}

__global__ void __launch_bounds__(256) k_moe_final(const float* __restrict__ X1, const bf16* __restrict__ H2, const int2* __restrict__ SEL_E, const float2* __restrict__ SEL_W, const float* __restrict__ Wg,
                                                   const float* __restrict__ Wu, const float* __restrict__ Wd, const float* __restrict__ fg, float* out) {
    __shared__ float hs[1024], act[256], red[4];
    const int m = blockIdx.x, tid = threadIdx.x;
    for (int i = tid; i < 1024; i += 256) hs[i] = bf2f(H2[(size_t)m * D + i]);
    __syncthreads();
    const int2 se = SEL_E[m]; const float2 sw = SEL_W[m];
    float o[4] = {0, 0, 0, 0};
    for (int s = 0; s < 2; ++s) { const int e = s ? se.y : se.x; const float w = s ? sw.y : sw.x;
        const float* wg = Wg + (size_t)e * 1024 * 256 + tid; const float* wu = Wu + (size_t)e * 1024 * 256 + tid;
        float ga = 0.f, ua = 0.f;
        for (int k = 0; k < 1024; ++k) { ga += hs[k] * wg[(size_t)k * 256]; ua += hs[k] * wu[(size_t)k * 256]; }
        act[tid] = ga / (1.f + expf(-ga)) * ua * w;
        __syncthreads();
        const float* wd = Wd + (size_t)e * 256 * 1024 + tid;
        for (int j = 0; j < 256; ++j) { const float a = act[j];
#pragma unroll
            for (int i = 0; i < 4; ++i) o[i] += a * wd[(size_t)j * 1024 + 256 * i]; }
        __syncthreads(); }
    float x2[4]; float ss = 0.f;
#pragma unroll
    for (int i = 0; i < 4; ++i) { x2[i] = X1[(size_t)m * D + tid + 256 * i] + o[i]; ss += x2[i] * x2[i]; }
    ss = wave_sum(ss);
    if ((tid & 63) == 0) red[tid >> 6] = ss;
    __syncthreads();
    const float rs = rsqrtf((red[0] + red[1] + red[2] + red[3]) * (1.f / D) + 1e-6f);
    __syncthreads();
#pragma unroll
    for (int i = 0; i < 4; ++i) out[(size_t)m * D + tid + 256 * i] = x2[i] * rs * fg[tid + 256 * i];
}
}

extern "C" void kernel_launch(void* const* d_in, const int* in_sizes, int n_in, void* d_out, int out_size, void* d_ws, size_t ws_size, hipStream_t stream) {
    auto F = [&](int i) { return (const float*)d_in[i]; };
    char* ws = (char*)d_ws; char* ob = (char*)d_out;
    bf16* H1 = (bf16*)ob;
    bf16* R = (bf16*)ob, *KK = (bf16*)(ob + 16 * MiB), *BV = (bf16*)(ob + 32 * MiB), *KM = (bf16*)(ob + 48 * MiB);
    bf16* PA = (bf16*)(ws + WS_PA), *ZB = (bf16*)(ws + WS_ZB), *GT = (bf16*)(ws + WS_GT), *LW = (bf16*)(ws + WS_LW), *VV = (bf16*)(ws + WS_VV), *GG = (bf16*)(ws + WS_GG);
    bf16* YB = (bf16*)(ws + WS_YB), *YA = (bf16*)(ws + WS_YA), *MIX = (bf16*)(ws + WS_MIX), *H2 = (bf16*)(ws + WS_H2);
    float* Y = (float*)(ws + WS_Y); float* X1 = (float*)(ws + WS_GT);
    int2* SEL_E = (int2*)(ws + WS_SEL); float2* SEL_W = (float2*)(ws + WS_SEL + 256 * 1024);
    k_rms_bf16<<<M / 4, 256, 0, stream>>>(F(0), F(1), H1);
    k_gemm1<<<dim3((IN_COLS + 255) / 256, M / 8), 256, 0, stream>>>(H1, F(2), F(3), PA, ZB, GT);
    k_prep<<<M, 512, 0, stream>>>(PA, F(4), F(5), F(6), F(7), F(8), F(9), F(10), F(11), R, KK, BV, KM, LW, VV, GG);
    k_gmlp<<<BATCH * 16 * 4 * 2, 256, 0, stream>>>(ZB, F(16), F(17), F(18), F(19), YB);
    k_wkv_naive<<<64, 64, 0, stream>>>(R, KK, BV, KM, LW, VV, Y);
    k_post<<<M, 512, 0, stream>>>(Y, R, KM, VV, GG, F(12), F(13), F(14), YA);
    k_mix<<<dim3(D / 256, M / 8), 256, 0, stream>>>(YA, YB, GT, F(15), F(20), MIX);
    k_wout<<<dim3(D / 256, M / 8), 256, 0, stream>>>(MIX, F(21), F(0), X1);
    k_router<<<M / 4, 256, 0, stream>>>(X1, F(22), F(23), F(24), F(25), F(26), H2, SEL_E, SEL_W);
    k_moe_final<<<M, 256, 0, stream>>>(X1, H2, SEL_E, SEL_W, F(27), F(28), F(29), F(30), (float*)d_out);
}
```

```cpp
#include <hip/hip_runtime.h>
#include <stdint.h>
#include <math.h>

namespace {
typedef unsigned short bf16;
constexpr int D = 1024, BATCH = 8, T = 2048, M = BATCH * T;
constexpr int AW = 512;
constexpr int A_COLS = 1824, B_COLS = 1024, IN_COLS = 4896;
constexpr int PA_LD = 2048;
constexpr size_t MiB = 1u << 20;
constexpr size_t WS_PA = 16 * MiB, WS_ZB = 80 * MiB, WS_GT = 112 * MiB, WS_LW = 176 * MiB, WS_VV = 192 * MiB, WS_GG = 208 * MiB,
                 WS_YB = 224 * MiB, WS_YA = 240 * MiB, WS_Y = 16 * MiB  , WS_MIX = 48 * MiB, WS_H2 = 80 * MiB, WS_SEL = 15 * MiB;

__device__ __forceinline__ float bf2f(bf16 b) { return __uint_as_float(((unsigned)b) << 16); }
__device__ __forceinline__ bf16 f2bf(float f) { unsigned u = __float_as_uint(f); u += 0x7fffu + ((u >> 16) & 1u); return (bf16)(u >> 16); }
__device__ __forceinline__ float wave_sum(float v) {
#pragma unroll
    for (int o = 1; o < 64; o <<= 1) v += __shfl_xor(v, o);
    return v;
}
__device__ __forceinline__ float sigmoidf_(float x) { return 1.f / (1.f + expf(-x)); }

__global__ void __launch_bounds__(256) k_rms_bf16(const float* __restrict__ x, const float* __restrict__ g, bf16* __restrict__ out) {
    const int row = blockIdx.x * 4 + (threadIdx.x >> 6), lane = threadIdx.x & 63;
    const float4* xr = (const float4*)(x + (size_t)row * D) + lane;
    float4 v[4]; float s = 0.f;
#pragma unroll
    for (int j = 0; j < 4; ++j) { v[j] = xr[64 * j]; s += v[j].x * v[j].x + v[j].y * v[j].y + v[j].z * v[j].z + v[j].w * v[j].w; }
    s = wave_sum(s);
    const float rs = rsqrtf(s * (1.f / D) + 1e-6f);
#pragma unroll
    for (int j = 0; j < 4; ++j) { const int c = 4 * lane + 256 * j; bf16* o = out + (size_t)row * D + c;
        o[0] = f2bf(v[j].x * rs * g[c]); o[1] = f2bf(v[j].y * rs * g[c + 1]); o[2] = f2bf(v[j].z * rs * g[c + 2]); o[3] = f2bf(v[j].w * rs * g[c + 3]); }
}

__device__ __forceinline__ void ngemm_acc(const bf16* __restrict__ A, int lda, const float* __restrict__ W, int ldw, int K, int m0, int n, bool nok, float (&acc)[8], float* As) {
    __syncthreads();
    for (int idx = threadIdx.x; idx < 8 * K; idx += 256) { const int i = idx / K, k = idx - i * K; As[i * 1024 + k] = bf2f(A[(size_t)(m0 + i) * lda + k]); }
    __syncthreads();
    if (nok) {
        for (int k = 0; k < K; ++k) { const float w = W[(size_t)k * ldw + n];
#pragma unroll
            for (int i = 0; i < 8; ++i) acc[i] += As[i * 1024 + k] * w; }
    }
}

__global__ void __launch_bounds__(256) k_gemm1(const bf16* __restrict__ H1, const float* __restrict__ w_in, const float* __restrict__ b_gate, bf16* PA, bf16* ZB, bf16* GT) {
    __shared__ float As[8 * 1024];
    const int n = blockIdx.x * 256 + threadIdx.x, m0 = blockIdx.y * 8; const bool nok = n < IN_COLS;
    float acc[8] = {0, 0, 0, 0, 0, 0, 0, 0};
    ngemm_acc(H1, D, w_in, IN_COLS, D, m0, n, nok, acc, As);
    if (!nok) return;
#pragma unroll
    for (int i = 0; i < 8; ++i) { const size_t m = m0 + i; const float p = acc[i];
        if (n < A_COLS) PA[m * PA_LD + n] = f2bf(p);
        else if (n < A_COLS + B_COLS) ZB[m * 1024 + (n - A_COLS)] = f2bf(0.5f * p * (1.f + erff(p * 0.70710678118f)));
        else { const int c = n - A_COLS - B_COLS; GT[m * 2048 + c] = f2bf(sigmoidf_(p + b_gate[c])); } }
}

__global__ void __launch_bounds__(512) k_prep(const bf16* __restrict__ PA, const float* __restrict__ mu, const float* __restrict__ w0, const float* __restrict__ w2, const float* __restrict__ a0,
                                              const float* __restrict__ a2, const float* __restrict__ g2, const float* __restrict__ k_k, const float* __restrict__ k_a,
                                              bf16* R, bf16* KK, bf16* BV, bf16* KM, bf16* LW, bf16* VV, bf16* GG) {
    __shared__ float xs[288];
    const int m = blockIdx.x, t = m & (T - 1), c = threadIdx.x;
    const bf16* p = PA + (size_t)m * PA_LD; const bf16* pp = p - PA_LD;
    auto lerp = [&](int col) { const float cur = bf2f(p[col]); const float prev = t > 0 ? bf2f(pp[col]) : 0.f; return cur + mu[col] * (prev - cur); };
    const float r = lerp(c), k = lerp(512 + c), v = lerp(1024 + c);
    if (c < 288) { float xv = lerp(1536 + c); if (c < 64) xv = tanhf(xv); else if (c >= 128) xv = sigmoidf_(xv); xs[c] = xv; }
    __syncthreads();
    float wp = w0[c], ap = a0[c], gp = 0.f;
#pragma unroll 8
    for (int q = 0; q < 64; ++q) { wp += xs[q] * w2[q * 512 + c]; ap += xs[64 + q] * a2[q * 512 + c]; }
#pragma unroll 8
    for (int q = 0; q < 160; ++q) gp += xs[128 + q] * g2[q * 512 + c];
    const float lw = -0.60653066f * sigmoidf_(wp);
    const float a = sigmoidf_(ap);
    float kk = k * k_k[c];
    const float ss = wave_sum(kk * kk);
    kk = kk / fmaxf(sqrtf(ss), 1e-12f);
    const float km = k * (1.f + (a - 1.f) * k_a[c]);
    const size_t o = (size_t)m * AW + c;
    R[o] = f2bf(r); KK[o] = f2bf(kk); BV[o] = f2bf(kk * a); KM[o] = f2bf(km); LW[o] = f2bf(lw); VV[o] = f2bf(v); GG[o] = f2bf(gp);
}

__global__ void __launch_bounds__(256) k_gmlp(const bf16* __restrict__ ZB, const float* __restrict__ lnv_g, const float* __restrict__ lnv_b, const float* __restrict__ w_s, const float* __restrict__ b_s, bf16* YB) {
    __shared__ float vn[128][64];
    __shared__ float s_mean[128], s_rstd[128];
    const int dh = blockIdx.x & 1, g = (blockIdx.x >> 1) & 3, bc = blockIdx.x >> 3;
    const int wave = threadIdx.x >> 6, lane = threadIdx.x & 63; const size_t m0 = (size_t)bc * 128;
    for (int s = wave * 32; s < wave * 32 + 32; ++s) { const bf16* vr = ZB + (m0 + s) * 1024 + 512;
        float x[8]; float sum = 0.f;
#pragma unroll
        for (int j = 0; j < 8; ++j) { x[j] = bf2f(vr[lane + 64 * j]); sum += x[j]; }
        const float mean = wave_sum(sum) * (1.f / 512.f); float q = 0.f;
#pragma unroll
        for (int j = 0; j < 8; ++j) { const float d = x[j] - mean; q += d * d; }
        const float var = wave_sum(q) * (1.f / 512.f);
        if (lane == 0) { s_mean[s] = mean; s_rstd[s] = rsqrtf(var + 1e-5f); } }
    __syncthreads();
    const int ch0 = g * 128 + dh * 64;
    for (int idx = threadIdx.x; idx < 128 * 64; idx += 256) { const int s = idx >> 6, dd = idx & 63; const int ch = ch0 + dd;
        vn[s][dd] = (bf2f(ZB[(m0 + s) * 1024 + 512 + ch]) - s_mean[s]) * s_rstd[s] * lnv_g[ch] + lnv_b[ch]; }
    __syncthreads();
    const int dd = threadIdx.x & 63, tq = threadIdx.x >> 6;
    for (int t = tq * 32; t < tq * 32 + 32; ++t) { const float* wr = w_s + ((size_t)g * 128 + t) * 128; float acc = 0.f;
        for (int s = 0; s <= t; ++s) acc += wr[s] * vn[s][dd];
        const float sv = acc + b_s[g * 128 + t]; const size_t m = m0 + t; const float u = bf2f(ZB[m * 1024 + ch0 + dd]);
        YB[m * AW + ch0 + dd] = f2bf(u * sv); }
}

__global__ void __launch_bounds__(64) k_wkv_naive(const bf16* __restrict__ R, const bf16* __restrict__ KK, const bf16* __restrict__ BV, const bf16* __restrict__ KM, const bf16* __restrict__ LW,
                                                  const bf16* __restrict__ VV, float* Y) {
    __shared__ float va[64], vb[64], vk[64], vr[64], vd[64];
    const int b = blockIdx.x >> 3, h = blockIdx.x & 7, lane = threadIdx.x;
    float s[64];
#pragma unroll
    for (int j = 0; j < 64; ++j) s[j] = 0.f;
    for (int t = 0; t < T; ++t) { const size_t o = ((size_t)b * T + t) * AW + h * 64 + lane;
        va[lane] = -bf2f(KK[o]); vb[lane] = bf2f(BV[o]); vk[lane] = bf2f(KM[o]); vr[lane] = bf2f(R[o]); vd[lane] = expf(bf2f(LW[o]));
        const float v = bf2f(VV[o]);
        __syncthreads();
        float sa = 0.f;
#pragma unroll
        for (int j = 0; j < 64; ++j) sa += s[j] * va[j];
        float y = 0.f;
#pragma unroll
        for (int j = 0; j < 64; ++j) { s[j] = s[j] * vd[j] + sa * vb[j] + v * vk[j]; y += s[j] * vr[j]; }
        Y[o] = y;
        __syncthreads(); }
}

__global__ void __launch_bounds__(512) k_post(const float* __restrict__ Y, const bf16* __restrict__ R, const bf16* __restrict__ KM, const bf16* __restrict__ VV, const bf16* __restrict__ GG,
                                              const float* __restrict__ r_k, const float* __restrict__ lnx_g, const float* __restrict__ lnx_b, bf16* YA) {
    const int c = threadIdx.x; const size_t o = (size_t)blockIdx.x * AW + c;
    const float y = Y[o]; const float mean = wave_sum(y) * (1.f / 64.f); const float d = y - mean; const float var = wave_sum(d * d) * (1.f / 64.f);
    const float yn = d * rsqrtf(var + 64e-5f) * lnx_g[c] + lnx_b[c];
    const float r = bf2f(R[o]), km = bf2f(KM[o]), v = bf2f(VV[o]), g = bf2f(GG[o]);
    const float bonus = wave_sum(r * km * r_k[c]) * v;
    YA[o] = f2bf((yn + bonus) * g);
}

__global__ void __launch_bounds__(256) k_mix(const bf16* __restrict__ YA, const bf16* __restrict__ YB, const bf16* __restrict__ GT, const float* __restrict__ w_oA, const float* __restrict__ w_oB, bf16* MIX) {
    __shared__ float As[8 * 1024];
    const int n = blockIdx.x * 256 + threadIdx.x, m0 = blockIdx.y * 8;
    float a1[8] = {0, 0, 0, 0, 0, 0, 0, 0}, a2[8] = {0, 0, 0, 0, 0, 0, 0, 0};
    ngemm_acc(YA, AW, w_oA, D, AW, m0, n, true, a1, As);
    ngemm_acc(YB, AW, w_oB, D, AW, m0, n, true, a2, As);
#pragma unroll
    for (int i = 0; i < 8; ++i) { const size_t m = m0 + i; MIX[m * D + n] = f2bf(bf2f(GT[m * 2048 + n]) * a1[i] + bf2f(GT[m * 2048 + 1024 + n]) * a2[i]); }
}
__global__ void __launch_bounds__(256) k_wout(const bf16* __restrict__ MIX, const float* __restrict__ w_out, const float* __restrict__ x, float* X1) {
    __shared__ float As[8 * 1024];
    const int n = blockIdx.x * 256 + threadIdx.x, m0 = blockIdx.y * 8;
    float acc[8] = {0, 0, 0, 0, 0, 0, 0, 0};
    ngemm_acc(MIX, D, w_out, D, D, m0, n, true, acc, As);
#pragma unroll
    for (int i = 0; i < 8; ++i) { const size_t m = m0 + i; X1[m * D + n] = x[m * D + n] + acc[i]; }
}

__global__ void __launch_bounds__(256) k_router(const float* __restrict__ X1, const float* __restrict__ g2n, const float* __restrict__ w_rg, const float* __restrict__ b_rg, const float* __restrict__ w_re,
                                                const float* __restrict__ b_re, bf16* H2, int2* SEL_E, float2* SEL_W) {
    const int m = blockIdx.x * 4 + (threadIdx.x >> 6), lane = threadIdx.x & 63;
    const float4* xr = (const float4*)(X1 + (size_t)m * D) + lane;
    float h[16]; float s = 0.f;
#pragma unroll
    for (int j = 0; j < 4; ++j) { const float4 v = xr[64 * j]; h[4 * j] = v.x; h[4 * j + 1] = v.y; h[4 * j + 2] = v.z; h[4 * j + 3] = v.w; s += v.x * v.x + v.y * v.y + v.z * v.z + v.w * v.w; }
    const float rs = rsqrtf(wave_sum(s) * (1.f / D) + 1e-6f);
#pragma unroll
    for (int j = 0; j < 4; ++j)
#pragma unroll
        for (int i = 0; i < 4; ++i) { const int c = 4 * lane + 256 * j + i; h[4 * j + i] *= rs * g2n[c]; H2[(size_t)m * D + c] = f2bf(h[4 * j + i]); }
    float gl[4];
#pragma unroll
    for (int gi = 0; gi < 4; ++gi) { float p = 0.f;
#pragma unroll
        for (int j = 0; j < 4; ++j)
#pragma unroll
            for (int i = 0; i < 4; ++i) { const int c = 4 * lane + 256 * j + i; p += h[4 * j + i] * w_rg[c * 4 + gi]; }
        gl[gi] = wave_sum(p) + b_rg[gi]; }
    int gs = 0; float gm = gl[0];
#pragma unroll
    for (int gi = 1; gi < 4; ++gi) if (gl[gi] > gm) { gm = gl[gi]; gs = gi; }
    float den = 0.f;
#pragma unroll
    for (int gi = 0; gi < 4; ++gi) den += expf(gl[gi] - gm);
    const float gp = 1.f / den;
    float el[8];
#pragma unroll
    for (int e = 0; e < 8; ++e) { float p = 0.f;
#pragma unroll
        for (int j = 0; j < 4; ++j)
#pragma unroll
            for (int i = 0; i < 4; ++i) { const int c = 4 * lane + 256 * j + i; p += h[4 * j + i] * w_re[((size_t)gs * D + c) * 8 + e]; }
        el[e] = wave_sum(p) + b_re[gs * 8 + e]; }
    int i1 = 0; float m1 = el[0];
#pragma unroll
    for (int e = 1; e < 8; ++e) if (el[e] > m1) { m1 = el[e]; i1 = e; }
    int i2 = -1; float m2 = -INFINITY;
#pragma unroll
    for (int e = 0; e < 8; ++e) if (e != i1 && el[e] > m2) { m2 = el[e]; i2 = e; }
    const float w1 = 1.f / (1.f + expf(m2 - m1)), w2 = 1.f - w1;
    if (lane == 0) { SEL_E[m] = make_int2(gs * 8 + i1, gs * 8 + i2); SEL_W[m] = make_float2(w1 * gp, w2 * gp); }
}

__global__ void __launch_bounds__(256) k_moe_final(const float* __restrict__ X1, const bf16* __restrict__ H2, const int2* __restrict__ SEL_E, const float2* __restrict__ SEL_W, const float* __restrict__ Wg,
                                                   const float* __restrict__ Wu, const float* __restrict__ Wd, const float* __restrict__ fg, float* out) {
    __shared__ float hs[1024], act[256], red[4];
    const int m = blockIdx.x, tid = threadIdx.x;
    for (int i = tid; i < 1024; i += 256) hs[i] = bf2f(H2[(size_t)m * D + i]);
    __syncthreads();
    const int2 se = SEL_E[m]; const float2 sw = SEL_W[m];
    float o[4] = {0, 0, 0, 0};
    for (int s = 0; s < 2; ++s) { const int e = s ? se.y : se.x; const float w = s ? sw.y : sw.x;
        const float* wg = Wg + (size_t)e * 1024 * 256 + tid; const float* wu = Wu + (size_t)e * 1024 * 256 + tid;
        float ga = 0.f, ua = 0.f;
        for (int k = 0; k < 1024; ++k) { ga += hs[k] * wg[(size_t)k * 256]; ua += hs[k] * wu[(size_t)k * 256]; }
        act[tid] = ga / (1.f + expf(-ga)) * ua * w;
        __syncthreads();
        const float* wd = Wd + (size_t)e * 256 * 1024 + tid;
        for (int j = 0; j < 256; ++j) { const float a = act[j];
#pragma unroll
            for (int i = 0; i < 4; ++i) o[i] += a * wd[(size_t)j * 1024 + 256 * i]; }
        __syncthreads(); }
    float x2[4]; float ss = 0.f;
#pragma unroll
    for (int i = 0; i < 4; ++i) { x2[i] = X1[(size_t)m * D + tid + 256 * i] + o[i]; ss += x2[i] * x2[i]; }
    ss = wave_sum(ss);
    if ((tid & 63) == 0) red[tid >> 6] = ss;
    __syncthreads();
    const float rs = rsqrtf((red[0] + red[1] + red[2] + red[3]) * (1.f / D) + 1e-6f);
    __syncthreads();
#pragma unroll
    for (int i = 0; i < 4; ++i) out[(size_t)m * D + tid + 256 * i] = x2[i] * rs * fg[tid + 256 * i];
}

#define LAS __attribute__((address_space(3)))
#define GAS __attribute__((address_space(1)))
typedef short bf16x8 __attribute__((ext_vector_type(8)));
typedef float f32x4 __attribute__((ext_vector_type(4)));
typedef float f32x2 __attribute__((ext_vector_type(2)));
typedef unsigned u32x4 __attribute__((ext_vector_type(4)));
typedef unsigned u32x2 __attribute__((ext_vector_type(2)));

namespace pg8 {
constexpr int BM = 256, BK = 64, HALF = 128, HTB = HALF * BK * 2, STAGE_BYTES = 8 * HTB, NXCD = 8, WGM = 8;
__device__ __forceinline__ int lds_byte(int r, int c) { const int st = (r >> 4) * 2 + (c >> 5), rr = r & 15, cc = c & 31, ob = rr * 64 + cc * 2; return st * 1024 + (ob ^ (((ob >> 9) & 1) << 5)); }
__device__ __forceinline__ void stage_rc(int b, int& R, int& C) { const int st = b / 1024, sb = b % 1024, swz = sb ^ (((sb >> 9) & 1) << 5); R = (st >> 1) * 16 + swz / 64; C = (st & 1) * 32 + (swz % 64) / 2; }
__device__ __forceinline__ int perm32(int rho) { const int n = rho >> 4, i = rho & 15; return 8 * (i >> 2) + 4 * n + (i & 3); }

struct Unit { int pm, pn; const char* A; const char* B; int aux; };
struct Gemm { int lda, ldb, K; };

__device__ __forceinline__ void tile_order(int L, int nM, int nN, int& pm, int& pn) {
    const int nwg = nM * nN; int wgid = L; { const int q = nwg / NXCD, r = nwg % NXCD, xcd = wgid % NXCD, off = wgid / NXCD; wgid = (xcd < r ? xcd * (q + 1) : r * (q + 1) + (xcd - r) * q) + off; }
    const int nig = WGM * nN, gid = wgid / nig, fm = gid * WGM, gsz = (nM - fm) < WGM ? (nM - fm) : WGM;
    pm = fm + ((wgid % nig) % gsz); pn = (wgid % nig) / gsz;
}
struct StaticOrder {
    const char* A; const char* B; int lda, ldb, nM, nN, nwg, G, c;
    __device__ void init(const void* A_, const void* B_, int lda_, int ldb_, int M, int N, int G_, int c_) { A = (const char*)A_; B = (const char*)B_; lda = lda_; ldb = ldb_; nM = M / BM; nN = N / BM; nwg = nM * nN; G = G_; c = c_; }
    __device__ __forceinline__ bool next(int i, Unit& u) const {
        const int L = i * G + c; if (L >= nwg) return false;
        tile_order(L, nM, nN, u.pm, u.pn);
        u.A = A + (size_t)u.pm * BM * lda * 2; u.B = B + (size_t)u.pn * BM * ldb * 2; u.aux = 0; return true;
    }
};

__device__ __forceinline__ unsigned cvt_pk_bf16(float lo, float hi) { unsigned r; asm volatile("v_cvt_pk_bf16_f32 %0, %1, %2" : "=v"(r) : "v"(lo), "v"(hi)); return r; }
__device__ __forceinline__ f32x2 gelu_pk(f32x2 v) {
    const f32x2 av = __builtin_elementwise_abs(v), d = av * 0.2316418882f + 1.0f;
    f32x2 t; t.x = __builtin_amdgcn_rcpf(d.x); t.y = __builtin_amdgcn_rcpf(d.y);
    f32x2 q = t * 0.5307027145f + (-0.7265760135f); q = q * t + 0.7107068705f; q = q * t + (-0.142248368f); q = q * t + 0.127414796f; q = q * t;
    const f32x2 s = (v * v) * (-0.72134752044f);
    f32x2 e; e.x = __builtin_amdgcn_exp2f(s.x); e.y = __builtin_amdgcn_exp2f(s.y);
    const f32x2 m = v * (q * e), r = v - m;
    f32x2 o; o.x = v.x < 0.f ? m.x : r.x; o.y = v.y < 0.f ? m.y : r.y; return o;
}
__device__ __forceinline__ float fast_sigmoid(float x) { return __builtin_amdgcn_rcpf(1.0f + __builtin_amdgcn_exp2f(-1.4426950408889634f * x)); }

template <class Epi, class Sched, bool ALIGN_EPI, bool SP2>
__device__ __forceinline__ void gemm_phase(LAS unsigned char* lds, const Gemm g, const Sched& S, const Epi& E) {
    const int tid = threadIdx.x, wid = __builtin_amdgcn_readfirstlane(tid >> 6), lane = tid & 63, wr = wid >> 2, wc = wid & 3, fr = lane & 15, fq = lane >> 4;
    const int K = g.K, nt = K / BK;
    unsigned voffA[2], voffB[2];
#pragma unroll
    for (int i = 0; i < 2; ++i) { int R, C; stage_rc(tid * 16 + i * 8192, R, C); const int Rb = Epi::PERM ? ((R & ~31) + perm32(R & 31)) : R;
        voffA[i] = (unsigned)(R * g.lda + C) * 2u; voffB[i] = (unsigned)(Rb * g.ldb + C) * 2u; }
    const size_t kstep = (size_t)(BK * 2);
    const size_t hstepA = (size_t)HALF * g.lda * 2, hstepB = (size_t)HALF * g.ldb * 2;
    const unsigned ldsw = (unsigned)wid * 1024u;
    const int aoff = lds_byte(wr * 64 + fr, fq * 8), boff = lds_byte(wc * 32 + fr, fq * 8);
#define PG8_SA(b, h) (((b) * 2 + (h)) * HTB)
#define PG8_SB(b, h) ((4 + (b) * 2 + (h)) * HTB)
#define PG8_STAGE(bufoff, gbase, voff) do { _Pragma("unroll") for (int _i = 0; _i < 2; ++_i) \
        __builtin_amdgcn_global_load_lds((const unsigned*)((const char*)(gbase) + (voff)[_i]), (LAS unsigned*)(lds + (bufoff) + ldsw + _i * 8192), 16, 0, 0); } while (0)
#define PG8_LDA(dst, b, h) do { _Pragma("unroll") for (int m = 0; m < 4; ++m) _Pragma("unroll") for (int k = 0; k < 2; ++k) dst[m][k] = *(const LAS bf16x8*)(lds + PG8_SA(b, h) + aoff + m * 2048 + k * 1024); } while (0)
#define PG8_LDB(dst, b, h) do { _Pragma("unroll") for (int n = 0; n < 2; ++n) _Pragma("unroll") for (int k = 0; k < 2; ++k) dst[n][k] = *(const LAS bf16x8*)(lds + PG8_SB(b, h) + boff + n * 2048 + k * 1024); } while (0)
#define PG8_MMA(ai, bj, At, Bt) do { __builtin_amdgcn_s_setprio(1); _Pragma("unroll") for (int m = 0; m < 4; ++m) _Pragma("unroll") for (int n = 0; n < 2; ++n) _Pragma("unroll") for (int k = 0; k < 2; ++k) \
        acc[ai][bj][m][n] = __builtin_amdgcn_mfma_f32_16x16x32_bf16(Bt[n][k], At[m][k], acc[ai][bj][m][n], 0, 0, 0); __builtin_amdgcn_s_setprio(0); } while (0)
#define PG8_WAIT_V(n) asm volatile("s_waitcnt vmcnt(" #n ")" ::: "memory")
#define PG8_WAIT_L(n) asm volatile("s_waitcnt lgkmcnt(" #n ")" ::: "memory")
#define PG8_BAR __builtin_amdgcn_s_barrier()
#define PG8_SCHED __builtin_amdgcn_sched_barrier(0)
    Unit cur, nxt; int ui = 0;
    if (!S.next(0, cur)) return;
    f32x4 acc[2][2][4][2];
#pragma unroll
    for (int a = 0; a < 2; ++a)
#pragma unroll
        for (int b = 0; b < 2; ++b)
#pragma unroll
            for (int m = 0; m < 4; ++m)
#pragma unroll
                for (int n = 0; n < 2; ++n) acc[a][b][m][n] = (f32x4){0.f, 0.f, 0.f, 0.f};
    bf16x8 At[4][2], B0[2][2], B1[2][2];
    const char* cA = cur.A; const char* cB = cur.B;
    if constexpr (SP2) {
        PG8_STAGE(PG8_SB(0, 0), cB, voffB); PG8_STAGE(PG8_SB(0, 1), cB + hstepB, voffB); PG8_STAGE(PG8_SA(0, 0), cA, voffA); PG8_STAGE(PG8_SA(0, 1), cA + hstepA, voffA);
        if (wr == 1) PG8_BAR;
        PG8_WAIT_V(2); PG8_BAR;
        PG8_STAGE(PG8_SB(1, 0), cB + kstep, voffB); PG8_STAGE(PG8_SA(1, 0), cA + kstep, voffA); PG8_STAGE(PG8_SB(1, 1), cB + hstepB + kstep, voffB);
        PG8_WAIT_V(6); PG8_BAR;
    } else {
        PG8_STAGE(PG8_SB(0, 0), cB, voffB); PG8_STAGE(PG8_SA(0, 0), cA, voffA); PG8_STAGE(PG8_SB(0, 1), cB + hstepB, voffB); PG8_STAGE(PG8_SA(0, 1), cA + hstepA, voffA);
        if (wr == 1) PG8_BAR;
        PG8_WAIT_V(4); PG8_BAR;
        PG8_STAGE(PG8_SB(1, 0), cB + kstep, voffB); PG8_STAGE(PG8_SA(1, 0), cA + kstep, voffA); PG8_STAGE(PG8_SB(1, 1), cB + hstepB + kstep, voffB);
        PG8_WAIT_V(6); PG8_BAR;
    }
    for (;;) {
        const bool has_next = S.next(ui + 1, nxt);
        const char* nA = has_next ? nxt.A : cA; const char* nB = has_next ? nxt.B : cB;
        for (int t = 0; t < nt; t += 2) {
            const bool last = (t == nt - 2);
            const char* a1 = cA + (size_t)(t + 1) * kstep;
            const char* a2 = last ? nA : cA + (size_t)(t + 2) * kstep; const char* b2 = last ? nB : cB + (size_t)(t + 2) * kstep;
            const char* a3 = a2 + kstep; const char* b3 = b2 + kstep;
            if constexpr (SP2) {
            PG8_LDB(B0, 0, 0); PG8_LDB(B1, 0, 1); PG8_SCHED; PG8_LDA(At, 0, 0); PG8_STAGE(PG8_SA(1, 1), a1 + hstepA, voffA);
            PG8_WAIT_V(8); PG8_WAIT_L(0); PG8_BAR; PG8_MMA(0, 0, At, B0); PG8_MMA(0, 1, At, B1); PG8_BAR; PG8_SCHED;
            PG8_LDA(At, 0, 1); PG8_STAGE(PG8_SB(0, 0), b2, voffB); PG8_STAGE(PG8_SB(0, 1), b2 + hstepB, voffB); PG8_STAGE(PG8_SA(0, 0), a2, voffA);
            PG8_WAIT_V(8); PG8_WAIT_L(0); PG8_BAR; PG8_MMA(1, 0, At, B0); PG8_MMA(1, 1, At, B1); PG8_BAR; PG8_SCHED;
            PG8_LDB(B0, 1, 0); PG8_LDB(B1, 1, 1); PG8_SCHED; PG8_LDA(At, 1, 0); PG8_STAGE(PG8_SA(0, 1), a2 + hstepA, voffA);
            PG8_WAIT_V(8); PG8_WAIT_L(0); PG8_BAR; PG8_MMA(0, 0, At, B0); PG8_MMA(0, 1, At, B1); PG8_BAR; PG8_SCHED;
            PG8_LDA(At, 1, 1); PG8_STAGE(PG8_SB(1, 0), b3, voffB); PG8_STAGE(PG8_SB(1, 1), b3 + hstepB, voffB); PG8_STAGE(PG8_SA(1, 0), a3, voffA);
            PG8_WAIT_V(8); PG8_WAIT_L(0); PG8_BAR; PG8_MMA(1, 0, At, B0); PG8_MMA(1, 1, At, B1); PG8_BAR; PG8_SCHED;
            } else {
            PG8_LDB(B0, 0, 0); PG8_SCHED; PG8_LDA(At, 0, 0); PG8_STAGE(PG8_SA(1, 1), a1 + hstepA, voffA);
            PG8_WAIT_L(8); PG8_BAR; PG8_WAIT_L(0); PG8_MMA(0, 0, At, B0); PG8_BAR; PG8_SCHED;
            PG8_LDB(B1, 0, 1); PG8_STAGE(PG8_SB(0, 0), b2, voffB);
            PG8_BAR; PG8_WAIT_L(0); PG8_MMA(0, 1, At, B1); PG8_BAR;
            PG8_LDA(At, 0, 1); PG8_STAGE(PG8_SA(0, 0), a2, voffA);
            PG8_BAR; PG8_WAIT_L(0); PG8_MMA(1, 0, At, B0); PG8_BAR; PG8_SCHED;
            PG8_STAGE(PG8_SB(0, 1), b2 + hstepB, voffB);
            PG8_WAIT_V(6); PG8_BAR; PG8_MMA(1, 1, At, B1); PG8_BAR;
            PG8_LDB(B0, 1, 0); PG8_SCHED; PG8_LDA(At, 1, 0); PG8_STAGE(PG8_SA(0, 1), a2 + hstepA, voffA);
            PG8_WAIT_L(8); PG8_BAR; PG8_WAIT_L(0); PG8_MMA(0, 0, At, B0); PG8_BAR; PG8_SCHED;
            PG8_LDB(B1, 1, 1); PG8_STAGE(PG8_SB(1, 0), b3, voffB);
            PG8_BAR; PG8_WAIT_L(0); PG8_MMA(0, 1, At, B1); PG8_BAR;
            PG8_LDA(At, 1, 1); PG8_STAGE(PG8_SA(1, 0), a3, voffA);
            PG8_BAR; PG8_WAIT_L(0); PG8_MMA(1, 0, At, B0); PG8_BAR; PG8_SCHED;
            PG8_STAGE(PG8_SB(1, 1), b3 + hstepB, voffB);
            PG8_WAIT_V(6); PG8_BAR; PG8_MMA(1, 1, At, B1); PG8_BAR;
            }
        }
        if constexpr (ALIGN_EPI) { if (wr == 0) PG8_BAR; }
        int l2 = lane; asm volatile("" : "+v"(l2));
        const bool keep = E(acc, cur, wr, wc, l2 & 15, l2 >> 4);
        if (!has_next) break;
        if (!keep) {
#pragma unroll
        for (int a = 0; a < 2; ++a)
#pragma unroll
            for (int b = 0; b < 2; ++b)
#pragma unroll
                for (int m = 0; m < 4; ++m)
#pragma unroll
                    for (int n = 0; n < 2; ++n) acc[a][b][m][n] = (f32x4){0.f, 0.f, 0.f, 0.f};
        }
        cur = nxt; cA = nA; cB = nB; ++ui;
        if constexpr (ALIGN_EPI) { if (wr == 1) PG8_BAR; }
    }
    PG8_WAIT_V(0);
    if constexpr (!ALIGN_EPI) { if (wr == 0) PG8_BAR; }
    PG8_BAR;
#undef PG8_SA
#undef PG8_SB
#undef PG8_STAGE
#undef PG8_LDA
#undef PG8_LDB
#undef PG8_MMA
#undef PG8_WAIT_V
#undef PG8_WAIT_L
#undef PG8_BAR
#undef PG8_SCHED
}
}

#define XB_TMO      128
#define XB_XCNT(j)  (256  + 64 * (j))
#define XB_XSUB(j)  (1280 + 64 * (j))
#define XB_XGEN(j)  (2304 + 64 * (j))
#define XB_TOP      3328
#define XB_TOPGEN   3392
#define XCD_BAR_WORDS 3456
#define XB_SPIN_CAP (1u << 20)
__device__ __forceinline__ unsigned xb_ld(unsigned* p)              { return __hip_atomic_load(p, __ATOMIC_RELAXED, __HIP_MEMORY_SCOPE_AGENT); }
__device__ __forceinline__ unsigned xb_add(unsigned* p, unsigned v) { return __hip_atomic_fetch_add(p, v, __ATOMIC_RELAXED, __HIP_MEMORY_SCOPE_AGENT); }
__device__ __forceinline__ unsigned xb_xcc_id() { return (unsigned)__builtin_amdgcn_s_getreg((3 << 11) | 20) & 0xFu; }
#define XB_SPIN(cond, bar) do { unsigned _sp = 0; while (cond) { __builtin_amdgcn_s_sleep(1); \
    if ((++_sp & 255u) == 0u) { if (xb_ld(&(bar)[XB_TMO])) break; if (_sp > XB_SPIN_CAP) { atomicAdd(&(bar)[XB_TMO], 1u); break; } } } } while (0)
struct XcdBarrier { unsigned* bar; unsigned x; volatile LAS unsigned* st; };
__device__ __forceinline__ XcdBarrier xcd_barrier_post(unsigned* bar, volatile LAS unsigned* st) {
    XcdBarrier b; b.bar = bar; b.x = xb_xcc_id(); b.st = st;
    if (threadIdx.x == 0) (void)xb_add(&bar[XB_XCNT(b.x)], 1u);
    return b;
}
__device__ __forceinline__ void xcd_barrier_complete(unsigned* bar, unsigned x, unsigned& nloc, unsigned& nx) {
    const unsigned G = gridDim.x * gridDim.y * gridDim.z;
    unsigned sum, cnt, mine, sp = 0u;
    for (;;) {
        sum = 0u; cnt = 0u; mine = 0u;
#pragma unroll
        for (unsigned j = 0; j < 16; ++j) { const unsigned c = xb_ld(&bar[XB_XCNT(j)]); sum += c; cnt += (c > 0u) ? 1u : 0u; mine = (j == x) ? c : mine; }
        if (sum == G) break;
        __builtin_amdgcn_s_sleep(1);
        if ((++sp & 255u) == 0u) { if (xb_ld(&bar[XB_TMO])) break; if (sp > XB_SPIN_CAP) { atomicAdd(&bar[XB_TMO], 1u); break; } }
    }
    nloc = mine > 0u ? mine : 1u; nx = cnt > 0u ? cnt : 1u;
}
__device__ __forceinline__ void xcd_barrier(const XcdBarrier& b) {
    asm volatile("s_waitcnt vmcnt(0)" ::: "memory");
    __syncthreads();
    if (threadIdx.x == 0) {
        unsigned* bar = b.bar;
        __builtin_amdgcn_s_waitcnt(0);
        unsigned nloc = b.st[0], nx = b.st[1];
        if (nloc == 0u) { xcd_barrier_complete(bar, b.x, nloc, nx); b.st[0] = nloc; b.st[1] = nx; }
        const unsigned old = xb_add(&bar[XB_XSUB(b.x)], 1u);
        const unsigned gen = old / nloc;
        if (old + 1u == (gen + 1u) * nloc) {
            __builtin_amdgcn_fence(__ATOMIC_RELEASE, "agent");
            asm volatile("s_waitcnt vmcnt(0)" ::: "memory");
            const unsigned og = xb_add(&bar[XB_TOP], 1u);
            const unsigned tg = og / nx;
            if (og + 1u == (tg + 1u) * nx) xb_add(&bar[XB_TOPGEN], 1u);
            else XB_SPIN(xb_ld(&bar[XB_TOPGEN]) == tg, bar);
            __builtin_amdgcn_fence(__ATOMIC_ACQUIRE, "agent");
            xb_add(&bar[XB_XGEN(b.x)], 1u);
            asm volatile("s_waitcnt vmcnt(0)" ::: "memory");
        } else {
            XB_SPIN(xb_ld(&bar[XB_XGEN(b.x)]) == gen, bar);
            __builtin_amdgcn_fence(__ATOMIC_ACQUIRE, "agent");
            asm volatile("s_waitcnt vmcnt(0)" ::: "memory");
        }
    }
    __syncthreads();
}

constexpr int NWAVES = 8, NTHREADS = 512;
constexpr int RING_BYTES = 131072, LDSCTL_OFF = RING_BYTES, MISC_OFF = LDSCTL_OFF + 320, LDS_BYTES = 147456;
constexpr int N1 = 5120;
constexpr size_t WS_CTL = 0, CTL_ZERO_BYTES = 256 * 1024;
constexpr int CW_BAR = 1024;
constexpr size_t WS_WIN = 1 * MiB  , WS_WOA = 11 * MiB, WS_WOB = 12 * MiB, WS_WOUT = 13 * MiB  ;
#define LDS_WAIT() asm volatile("s_waitcnt lgkmcnt(0)" ::: "memory")
constexpr size_t WS_HG = 16 * MiB, WS_YE = 16 * MiB, WS_ACT = 96 * MiB, WS_WGU = 176 * MiB, WS_WD = 208 * MiB, WS_H2M = 224 * MiB;
constexpr size_t WS_SELE = 15 * MiB, WS_SELW = WS_SELE + 128 * 1024, WS_SELP = WS_SELW + 128 * 1024, WS_ROW = WS_SELP + 128 * 1024;
constexpr int CW_CNT = 512;
constexpr int TAB_OFF = LDSCTL_OFF + 1024;

enum { PH_P0 = 0, PH_GEMM1, PH_PREP, PH_SCAN1, PH_SCAN2, PH_SCAN3, PH_MIX, PH_WOUT, PH_ROUTER, PH_GATHER, PH_MOE1, PH_MOE2, PH_FINAL, PH_END };
struct Args { const float* in[31]; float* out; unsigned char* ws; int ph_lo, ph_hi, li, pad; };

struct Frame { LAS unsigned char* lds; int wave, vcu, G; };
#define F_LANE ((int)(threadIdx.x & 63u))
#define F_TID ((int)threadIdx.x)

__device__ __forceinline__ unsigned pk2(float lo, float hi) { return (unsigned)f2bf(lo) | ((unsigned)f2bf(hi) << 16); }
__device__ __forceinline__ void p0_transpose_item(const float* __restrict__ W, int K, int N, bf16* WT, int ldt, int row_off, LAS float* scr, int kb, int nb, int lane) {
    const int k0 = 64 * kb, n0 = 32 * nb;
#pragma unroll 8
    for (int i = 0; i < 32; ++i) { const int kk = 2 * i + (lane >> 5); scr[kk * 33 + (lane & 31)] = W[(size_t)(k0 + kk) * N + n0 + (lane & 31)]; }
    LDS_WAIT(); asm volatile("" ::: "memory");
    const int c = lane & 7;
#pragma unroll
    for (int j = 0; j < 4; ++j) { const int n = (lane >> 3) + 8 * j; const LAS float* s = scr + (8 * c) * 33 + n;
        u32x4 o; o.x = pk2(s[0 * 33], s[1 * 33]); o.y = pk2(s[2 * 33], s[3 * 33]); o.z = pk2(s[4 * 33], s[5 * 33]); o.w = pk2(s[6 * 33], s[7 * 33]);
        *(u32x4*)(WT + (size_t)(row_off + n0 + n) * ldt + k0 + 8 * c) = o; }
    LDS_WAIT(); asm volatile("" ::: "memory");
}

struct Epi1 {
    static constexpr bool PERM = true;
    bf16* PA; bf16* ZB; bf16* GT; const float* b_gate;
    __device__ __forceinline__ bool operator()(f32x4 (&acc)[2][2][4][2], const pg8::Unit& u, int wr, int wc, int fr, int fq) const {
        const int row0 = u.pm * 256 + wr * 64 + fr;
        int mode, ldc, colt; bf16* base;
        if (u.pn < 8) { mode = 0; base = PA; ldc = PA_LD; colt = u.pn * 256; }
        else if (u.pn < 12) { mode = 1; base = ZB; ldc = 1024; colt = (u.pn - 8) * 256; }
        else { mode = 2; base = GT; ldc = 2048; colt = (u.pn - 12) * 256; }
        const int col0 = colt + wc * 32 + 8 * fq;
        f32x4 bv[2][2];
#pragma unroll
        for (int bj = 0; bj < 2; ++bj)
#pragma unroll
            for (int n = 0; n < 2; ++n) bv[bj][n] = (mode == 2) ? *(const f32x4*)(b_gate + col0 + bj * 128 + 4 * n) : (f32x4){0.f, 0.f, 0.f, 0.f};
#pragma unroll
        for (int ai = 0; ai < 2; ++ai)
#pragma unroll
            for (int m = 0; m < 4; ++m) { bf16* rowp = base + (size_t)(row0 + ai * 128 + m * 16) * ldc + col0;
#pragma unroll
                for (int bj = 0; bj < 2; ++bj) { f32x4 v0 = acc[ai][bj][m][0] + bv[bj][0], v1 = acc[ai][bj][m][1] + bv[bj][1];
                    if (mode == 1) { f32x2 a = pg8::gelu_pk((f32x2){v0[0], v0[1]}), b = pg8::gelu_pk((f32x2){v0[2], v0[3]}), c = pg8::gelu_pk((f32x2){v1[0], v1[1]}), d = pg8::gelu_pk((f32x2){v1[2], v1[3]});
                        v0 = (f32x4){a.x, a.y, b.x, b.y}; v1 = (f32x4){c.x, c.y, d.x, d.y}; }
                    if (mode == 2) {
#pragma unroll
                        for (int j = 0; j < 4; ++j) { v0[j] = pg8::fast_sigmoid(v0[j]); v1[j] = pg8::fast_sigmoid(v1[j]); } }
                    u32x4 w; w.x = pg8::cvt_pk_bf16(v0[0], v0[1]); w.y = pg8::cvt_pk_bf16(v0[2], v0[3]); w.z = pg8::cvt_pk_bf16(v1[0], v1[1]); w.w = pg8::cvt_pk_bf16(v1[2], v1[3]);
                    *(u32x4*)(rowp + bj * 128) = w; } }
        return false;
    }
};

struct MixOrder {
    const char *YA, *YB, *WA, *WB; int G, c;
    __device__ __forceinline__ bool next(int i, pg8::Unit& u) const {
        const int L = (i >> 1) * G + c; if (L >= 256) return false;
        pg8::tile_order(L, 64, 4, u.pm, u.pn); u.aux = i & 1;
        u.A = ((i & 1) ? YB : YA) + (size_t)u.pm * 256 * 512 * 2; u.B = ((i & 1) ? WB : WA) + (size_t)u.pn * 256 * 512 * 2; return true;
    }
};
__device__ __forceinline__ void unpack8(const u32x4 w, float (&f)[8]) {
    f[0] = __uint_as_float(w.x << 16); f[1] = __uint_as_float(w.x & 0xffff0000u); f[2] = __uint_as_float(w.y << 16); f[3] = __uint_as_float(w.y & 0xffff0000u);
    f[4] = __uint_as_float(w.z << 16); f[5] = __uint_as_float(w.z & 0xffff0000u); f[6] = __uint_as_float(w.w << 16); f[7] = __uint_as_float(w.w & 0xffff0000u);
}
struct EpiMix {
    static constexpr bool PERM = true;
    const bf16* GT; bf16* MIX;
    __device__ __forceinline__ bool operator()(f32x4 (&acc)[2][2][4][2], const pg8::Unit& u, int wr, int wc, int fr, int fq) const {
        const int row0 = u.pm * 256 + wr * 64 + fr, col0 = u.pn * 256 + wc * 32 + 8 * fq;
#pragma unroll
        for (int ai = 0; ai < 2; ++ai)
#pragma unroll
            for (int m = 0; m < 4; ++m) { const size_t row = (size_t)(row0 + ai * 128 + m * 16);
#pragma unroll
                for (int bj = 0; bj < 2; ++bj) { const int c = col0 + bj * 128;
                    float gb[8]; unpack8(*(const u32x4*)(GT + row * 2048 + 1024 + c), gb);
                    if (u.aux == 0) { float ga[8]; unpack8(*(const u32x4*)(GT + row * 2048 + c), ga);
#pragma unroll
                        for (int j = 0; j < 4; ++j) { acc[ai][bj][m][0][j] *= ga[j] * __builtin_amdgcn_rcpf(gb[j]); acc[ai][bj][m][1][j] *= ga[4 + j] * __builtin_amdgcn_rcpf(gb[4 + j]); }
                    } else { const f32x4 v0 = acc[ai][bj][m][0], v1 = acc[ai][bj][m][1];
                        u32x4 w; w.x = pg8::cvt_pk_bf16(v0[0] * gb[0], v0[1] * gb[1]); w.y = pg8::cvt_pk_bf16(v0[2] * gb[2], v0[3] * gb[3]);
                        w.z = pg8::cvt_pk_bf16(v1[0] * gb[4], v1[1] * gb[5]); w.w = pg8::cvt_pk_bf16(v1[2] * gb[6], v1[3] * gb[7]);
                        *(u32x4*)(MIX + row * 1024 + c) = w; } } }
        return u.aux == 0;
    }
};
struct EpiX1 {
    static constexpr bool PERM = false;
    const float* x; float* X1;
    __device__ __forceinline__ bool operator()(f32x4 (&acc)[2][2][4][2], const pg8::Unit& u, int wr, int wc, int fr, int fq) const {
        const int row0 = u.pm * 256 + wr * 64 + fr, col0 = u.pn * 256 + wc * 32 + 4 * fq;
#pragma unroll
        for (int ai = 0; ai < 2; ++ai)
#pragma unroll
            for (int m = 0; m < 4; ++m) { const size_t off = (size_t)(row0 + ai * 128 + m * 16) * 1024 + col0;
#pragma unroll
                for (int bj = 0; bj < 2; ++bj)
#pragma unroll
                    for (int n = 0; n < 2; ++n) *(f32x4*)(X1 + off + bj * 128 + n * 16) = *(const f32x4*)(x + off + bj * 128 + n * 16) + acc[ai][bj][m][n]; }
        return false;
    }
};

__device__ __forceinline__ void moe_tables(Frame& F, const unsigned* cnt) {
    volatile LAS int* tab = (volatile LAS int*)(F.lds + TAB_OFF);
    if (F_TID == 0) { int acc = 0; for (int e = 0; e < 32; ++e) { tab[e] = acc; acc += (int)((__hip_atomic_load(cnt + e, __ATOMIC_RELAXED, __HIP_MEMORY_SCOPE_AGENT) + 255u) >> 8); } tab[32] = acc; }
    __syncthreads();
}
struct MoeOrder {
    const char* A; const char* B; LAS const int* tab; int NT, nN, G, c; size_t a_tile, b_exp, b_tile;
    __device__ __forceinline__ bool next(int i, pg8::Unit& u) const {
        const int L = i * G + c; if (L >= NT * nN) return false;
        pg8::tile_order(L, NT, nN, u.pm, u.pn);
        int e = 0;
#pragma unroll 1
        for (int k = 1; k < 32; ++k) e += (u.pm >= tab[k]) ? 1 : 0;
        u.aux = e; u.A = A + (size_t)u.pm * a_tile; u.B = B + (size_t)e * b_exp + (size_t)u.pn * b_tile; return true;
    }
};
struct EpiAct {
    static constexpr bool PERM = true;
    bf16* ACT;
    __device__ __forceinline__ bool operator()(f32x4 (&acc)[2][2][4][2], const pg8::Unit& u, int wr, int wc, int fr, int fq) const {
        const int row0 = u.pm * 256 + wr * 64 + fr, col0 = u.pn * 128 + wc * 32 + 8 * fq;
#pragma unroll
        for (int ai = 0; ai < 2; ++ai)
#pragma unroll
            for (int m = 0; m < 4; ++m) { float o[8];
#pragma unroll
                for (int n = 0; n < 2; ++n)
#pragma unroll
                    for (int j = 0; j < 4; ++j) { const float g = acc[ai][0][m][n][j], up = acc[ai][1][m][n][j]; o[4 * n + j] = g * pg8::fast_sigmoid(g) * up; }
                u32x4 w; w.x = pg8::cvt_pk_bf16(o[0], o[1]); w.y = pg8::cvt_pk_bf16(o[2], o[3]); w.z = pg8::cvt_pk_bf16(o[4], o[5]); w.w = pg8::cvt_pk_bf16(o[6], o[7]);
                *(u32x4*)(ACT + (size_t)(row0 + ai * 128 + m * 16) * 256 + col0) = w; }
        return false;
    }
};
struct EpiYE {
    static constexpr bool PERM = true;
    bf16* YE;
    __device__ __forceinline__ bool operator()(f32x4 (&acc)[2][2][4][2], const pg8::Unit& u, int wr, int wc, int fr, int fq) const {
        const int row0 = u.pm * 256 + wr * 64 + fr, col0 = u.pn * 256 + wc * 32 + 8 * fq;
#pragma unroll
        for (int ai = 0; ai < 2; ++ai)
#pragma unroll
            for (int m = 0; m < 4; ++m) { bf16* rowp = YE + (size_t)(row0 + ai * 128 + m * 16) * 1024 + col0;
#pragma unroll
                for (int bj = 0; bj < 2; ++bj) { const f32x4 v0 = acc[ai][bj][m][0], v1 = acc[ai][bj][m][1];
                    u32x4 w; w.x = pg8::cvt_pk_bf16(v0[0], v0[1]); w.y = pg8::cvt_pk_bf16(v0[2], v0[3]); w.z = pg8::cvt_pk_bf16(v1[0], v1[1]); w.w = pg8::cvt_pk_bf16(v1[2], v1[3]);
                    *(u32x4*)(rowp + bj * 128) = w; } }
        return false;
    }
};

constexpr size_t WS_PHIT = 16 * MiB, WS_QT = 32 * MiB, WS_LT = 48 * MiB, WS_YL = 80 * MiB;
#define DPPQ(K) "quad_perm:[" #K "," #K "," #K "," #K "] row_mask:0xf bank_mask:0xf"
#define WKV_GROUP(P0, P1, P2, P3, L0, L1, L2, L3, VD, VB, VK, VR, VA) \
    asm volatile( \
        "v_mul_f32_dpp %0, %12, %0 " DPPQ(0) "\n\tv_mul_f32_dpp %4, %12, %4 " DPPQ(0) "\n\tv_mul_f32_dpp %1, %12, %1 " DPPQ(1) "\n\tv_mul_f32_dpp %5, %12, %5 " DPPQ(1) "\n\t" \
        "v_mul_f32_dpp %2, %12, %2 " DPPQ(2) "\n\tv_mul_f32_dpp %6, %12, %6 " DPPQ(2) "\n\tv_mul_f32_dpp %3, %12, %3 " DPPQ(3) "\n\tv_mul_f32_dpp %7, %12, %7 " DPPQ(3) "\n\t" \
        "v_fmac_f32_dpp %0, %13, %17 " DPPQ(0) "\n\tv_fmac_f32_dpp %4, %13, %18 " DPPQ(0) "\n\tv_fmac_f32_dpp %1, %13, %17 " DPPQ(1) "\n\tv_fmac_f32_dpp %5, %13, %18 " DPPQ(1) "\n\t" \
        "v_fmac_f32_dpp %2, %13, %17 " DPPQ(2) "\n\tv_fmac_f32_dpp %6, %13, %18 " DPPQ(2) "\n\tv_fmac_f32_dpp %3, %13, %17 " DPPQ(3) "\n\tv_fmac_f32_dpp %7, %13, %18 " DPPQ(3) "\n\t" \
        "v_fmac_f32_dpp %4, %14, %19 " DPPQ(0) "\n\tv_fmac_f32_dpp %5, %14, %19 " DPPQ(1) "\n\tv_fmac_f32_dpp %6, %14, %19 " DPPQ(2) "\n\tv_fmac_f32_dpp %7, %14, %19 " DPPQ(3) "\n\t" \
        "v_fmac_f32_dpp %8, %15, %0 " DPPQ(0) "\n\tv_fmac_f32_dpp %10, %16, %0 " DPPQ(0) "\n\tv_fmac_f32_dpp %9, %15, %4 " DPPQ(0) "\n\tv_fmac_f32_dpp %11, %16, %4 " DPPQ(0) "\n\t" \
        "v_fmac_f32_dpp %8, %15, %1 " DPPQ(1) "\n\tv_fmac_f32_dpp %10, %16, %1 " DPPQ(1) "\n\tv_fmac_f32_dpp %9, %15, %5 " DPPQ(1) "\n\tv_fmac_f32_dpp %11, %16, %5 " DPPQ(1) "\n\t" \
        "v_fmac_f32_dpp %8, %15, %2 " DPPQ(2) "\n\tv_fmac_f32_dpp %10, %16, %2 " DPPQ(2) "\n\tv_fmac_f32_dpp %9, %15, %6 " DPPQ(2) "\n\tv_fmac_f32_dpp %11, %16, %6 " DPPQ(2) "\n\t" \
        "v_fmac_f32_dpp %8, %15, %3 " DPPQ(3) "\n\tv_fmac_f32_dpp %10, %16, %3 " DPPQ(3) "\n\tv_fmac_f32_dpp %9, %15, %7 " DPPQ(3) "\n\tv_fmac_f32_dpp %11, %16, %7 " DPPQ(3) \
        : "+v"(P0), "+v"(P1), "+v"(P2), "+v"(P3), "+v"(L0), "+v"(L1), "+v"(L2), "+v"(L3), "+v"(q), "+v"(yl), "+v"(sa2p), "+v"(sa2l) \
        : "v"(VD), "v"(VB), "v"(VK), "v"(VR), "v"(VA), "v"(sa_p), "v"(sa_l), "v"(vv))

struct ScanBufs { const bf16 *R, *KK, *BV, *KM, *LW, *VV, *GG; bf16 *PHIT, *QT; float *LT, *YL; bf16 *XF; bf16* YA; };

__device__ __forceinline__ void scan_pass1(Frame& F, const ScanBufs& B) {
    LAS float* wl = (LAS float*)(F.lds + F.wave * 12288);
    const int lane = F_LANE, h = F.wave;
    for (int bc = F.vcu; bc < 256; bc += F.G) {
        const int b = bc >> 5, c = bc & 31; const size_t m0 = (size_t)b * T + c * 64; const int uid = (b * 8 + h) * 32 + c;
        float phi[64], l[64]; float one = 1.f; asm volatile("" : "+v"(one));
#pragma unroll
        for (int j = 0; j < 64; ++j) { phi[j] = (j == lane) ? one : 0.f; l[j] = 0.f; }
        float sa_p = -bf2f(B.KK[m0 * AW + h * 64 + lane]), sa_l = 0.f;
        const int ts = lane >> 3, c0 = 8 * (lane & 7);
        const size_t goff = (m0 + ts) * AW + h * 64 + c0;
        u32x4 pr[6];
        pr[0] = *(const u32x4*)(B.LW + goff); pr[1] = *(const u32x4*)(B.BV + goff); pr[2] = *(const u32x4*)(B.KM + goff); pr[3] = *(const u32x4*)(B.R + goff);
        pr[4] = *(const u32x4*)(B.KK + goff + AW); pr[5] = *(const u32x4*)(B.VV + goff);
        for (int sb = 0; sb < 8; ++sb) {
            asm volatile("" ::: "memory");
#pragma unroll
            for (int v = 0; v < 5; ++v) { float f[8]; unpack8(pr[v], f);
                if (v == 0) {
#pragma unroll
                    for (int i = 0; i < 8; ++i) f[i] = __expf(f[i]); }
                if (v == 4) {
#pragma unroll
                    for (int i = 0; i < 8; ++i) f[i] = -f[i]; }
                LAS float* dst = wl + (v * 8 + ts) * 64 + 2 * (lane & 7);
#pragma unroll
                for (int i = 0; i < 4; ++i) *(LAS f32x2*)(dst + 16 * i) = (f32x2){f[i], f[i + 4]}; }
            { float f[8]; unpack8(pr[5], f); LAS float* dst = wl + 2560 + ts * 64 + c0; *(LAS f32x4*)dst = (f32x4){f[0], f[1], f[2], f[3]}; *(LAS f32x4*)(dst + 4) = (f32x4){f[4], f[5], f[6], f[7]}; }
            asm volatile("" ::: "memory");
            if (sb < 7) { const size_t g2 = goff + (size_t)(sb + 1) * 8 * AW;
                pr[0] = *(const u32x4*)(B.LW + g2); pr[1] = *(const u32x4*)(B.BV + g2); pr[2] = *(const u32x4*)(B.KM + g2); pr[3] = *(const u32x4*)(B.R + g2);
                pr[4] = *(const u32x4*)(B.KK + g2 + AW); pr[5] = *(const u32x4*)(B.VV + g2); }
#pragma unroll 1
            for (int tt = 0; tt < 8; ++tt) {
                const LAS float* vb = wl + tt * 64 + 16 * (lane & 3);
                const float vv = wl[2560 + tt * 64 + lane];
                float q = 0.f, yl = 0.f, sa2p = 0.f, sa2l = 0.f;
                f32x4 vd = *(const LAS f32x4*)(vb), vbb = *(const LAS f32x4*)(vb + 512), vk = *(const LAS f32x4*)(vb + 1024), vr = *(const LAS f32x4*)(vb + 1536), va = *(const LAS f32x4*)(vb + 2048);
#pragma unroll
                for (int gc = 0; gc < 4; ++gc) {
                    f32x4 nd, nb, nk, nr, na;
                    if (gc < 3) { nd = *(const LAS f32x4*)(vb + 4 * gc + 4); nb = *(const LAS f32x4*)(vb + 512 + 4 * gc + 4); nk = *(const LAS f32x4*)(vb + 1024 + 4 * gc + 4);
                                  nr = *(const LAS f32x4*)(vb + 1536 + 4 * gc + 4); na = *(const LAS f32x4*)(vb + 2048 + 4 * gc + 4); }
                    __builtin_amdgcn_sched_barrier(0);
#pragma unroll
                    for (int gi = 0; gi < 4; ++gi) { const int g = 4 * gc + gi;
                        WKV_GROUP(phi[4 * g], phi[4 * g + 1], phi[4 * g + 2], phi[4 * g + 3], l[4 * g], l[4 * g + 1], l[4 * g + 2], l[4 * g + 3], vd[gi], vbb[gi], vk[gi], vr[gi], va[gi]); }
                    __builtin_amdgcn_sched_barrier(0);
                    if (gc < 3) { vd = nd; vbb = nb; vk = nk; vr = nr; va = na; }
                }
                const int t = sb * 8 + tt;
                B.QT[(size_t)uid * 4096 + t * 64 + lane] = f2bf(q);
                B.YL[(size_t)uid * 4096 + t * 64 + lane] = yl;
                sa_p = sa2p; sa_l = sa2l;
            }
        }
#pragma unroll
        for (int j = 0; j < 64; ++j) { B.PHIT[(size_t)uid * 4096 + j * 64 + lane] = f2bf(phi[j]); B.LT[(size_t)uid * 4096 + j * 64 + lane] = l[j]; }
    }
}

typedef float f32x16 __attribute__((ext_vector_type(16)));
__device__ __forceinline__ bf16x8 acc_frag(const f32x16& x, int s) {
    u32x4 w; w.x = pg8::cvt_pk_bf16(x[8 * s], x[8 * s + 1]); w.y = pg8::cvt_pk_bf16(x[8 * s + 2], x[8 * s + 3]); w.z = pg8::cvt_pk_bf16(x[8 * s + 4], x[8 * s + 5]); w.w = pg8::cvt_pk_bf16(x[8 * s + 6], x[8 * s + 7]);
    return __builtin_bit_cast(bf16x8, w);
}
__device__ __forceinline__ bf16x8 row_frag(const bf16* row, int s, int hh) {
    const u32x2 a = *(const u32x2*)(row + 16 * s + 4 * hh), b = *(const u32x2*)(row + 16 * s + 8 + 4 * hh);
    u32x4 w; w.x = a.x; w.y = a.y; w.z = b.x; w.w = b.y; return __builtin_bit_cast(bf16x8, w);
}
__device__ __forceinline__ void scan_pass2(Frame& F, const ScanBufs& B) {
    if (F.wave >= 2) return;
    const int it = F.wave, lane = F_LANE, l31 = lane & 31, hh = lane >> 5;
    for (int bh = F.vcu; bh < 64; bh += F.G) {
        f32x16 X[2];
#pragma unroll
        for (int jt = 0; jt < 2; ++jt)
#pragma unroll
            for (int r = 0; r < 16; ++r) X[jt][r] = 0.f;
        for (int c = 0; c < 32; ++c) { const size_t ub = ((size_t)bh * 32 + c) * 4096;
            bf16x8 xf[2][2];
#pragma unroll
            for (int jt = 0; jt < 2; ++jt)
#pragma unroll
                for (int s = 0; s < 2; ++s) { xf[jt][s] = acc_frag(X[jt], s);
                    *(bf16x8*)(B.XF + ub + (size_t)(((it * 2 + jt) * 2 + s) * 64 + lane) * 8) = xf[jt][s]; }
            f32x16 Xn[2];
#pragma unroll
            for (int j2 = 0; j2 < 2; ++j2)
#pragma unroll
                for (int r = 0; r < 16; ++r) Xn[j2][r] = B.LT[ub + (size_t)(32 * j2 + (r & 3) + 8 * (r >> 2) + 4 * hh) * 64 + 32 * it + l31];
#pragma unroll
            for (int j2 = 0; j2 < 2; ++j2) { const bf16* prow = B.PHIT + ub + (size_t)(32 * j2 + l31) * 64;
#pragma unroll
                for (int jt = 0; jt < 2; ++jt)
#pragma unroll
                    for (int s = 0; s < 2; ++s) Xn[j2] = __builtin_amdgcn_mfma_f32_32x32x16_bf16(row_frag(prow + 32 * jt, s, hh), xf[jt][s], Xn[j2], 0, 0, 0); }
            X[0] = Xn[0]; X[1] = Xn[1];
        }
    }
}
__device__ __forceinline__ void scan_pass3(Frame& F, const ScanBufs& B, const float* __restrict__ r_k, const float* __restrict__ lnx_g, const float* __restrict__ lnx_b) {
    const int lane = F_LANE, l31 = lane & 31, hh = lane >> 5, h = F.wave;
    for (int bc = F.vcu; bc < 256; bc += F.G) {
        const int b = bc >> 5, c = bc & 31; const size_t m0 = (size_t)b * T + c * 64; const size_t ub = ((size_t)(b * 8 + h) * 32 + c) * 4096;
        bf16x8 xa[2][2][2];
#pragma unroll
        for (int it = 0; it < 2; ++it)
#pragma unroll
            for (int jt = 0; jt < 2; ++jt)
#pragma unroll
                for (int s = 0; s < 2; ++s) xa[it][jt][s] = *(const bf16x8*)(B.XF + ub + (size_t)(((it * 2 + jt) * 2 + s) * 64 + lane) * 8);
#pragma unroll
        for (int tt = 0; tt < 2; ++tt) { const int t = 32 * tt + l31; const size_t m = m0 + t;
            f32x16 Y[2];
#pragma unroll
            for (int it = 0; it < 2; ++it)
#pragma unroll
                for (int g4 = 0; g4 < 4; ++g4) { const f32x4 y4 = *(const f32x4*)(B.YL + ub + (size_t)t * 64 + 32 * it + 8 * g4 + 4 * hh);
                    Y[it][4 * g4] = y4.x; Y[it][4 * g4 + 1] = y4.y; Y[it][4 * g4 + 2] = y4.z; Y[it][4 * g4 + 3] = y4.w; }
            const bf16* qrow = B.QT + ub + (size_t)t * 64;
#pragma unroll
            for (int jt = 0; jt < 2; ++jt)
#pragma unroll
                for (int s = 0; s < 2; ++s) { const bf16x8 qb = row_frag(qrow + 32 * jt, s, hh);
#pragma unroll
                    for (int it = 0; it < 2; ++it) Y[it] = __builtin_amdgcn_mfma_f32_32x32x16_bf16(xa[it][jt][s], qb, Y[it], 0, 0, 0); }
            float sum = 0.f;
#pragma unroll
            for (int it = 0; it < 2; ++it)
#pragma unroll
                for (int r = 0; r < 16; ++r) sum += Y[it][r];
            sum += __shfl_xor(sum, 32);
            const float mean = sum * (1.f / 64.f); float sq = 0.f;
#pragma unroll
            for (int it = 0; it < 2; ++it)
#pragma unroll
                for (int r = 0; r < 16; ++r) { const float d = Y[it][r] - mean; sq += d * d; }
            sq += __shfl_xor(sq, 32);
            const float rstd = rsqrtf(sq * (1.f / 64.f) + 64e-5f);
            float bsum = 0.f;
#pragma unroll
            for (int it = 0; it < 2; ++it)
#pragma unroll
                for (int g4 = 0; g4 < 4; ++g4) { const int ch = h * 64 + 32 * it + 8 * g4 + 4 * hh; const size_t o = m * AW + ch;
                    const u32x2 r2 = *(const u32x2*)(B.R + o), k2 = *(const u32x2*)(B.KM + o);
                    const f32x4 rk = *(const f32x4*)(r_k + ch);
                    const float r0 = __uint_as_float(r2.x << 16), r1 = __uint_as_float(r2.x & 0xffff0000u), r2f = __uint_as_float(r2.y << 16), r3 = __uint_as_float(r2.y & 0xffff0000u);
                    const float k0 = __uint_as_float(k2.x << 16), k1 = __uint_as_float(k2.x & 0xffff0000u), k2f = __uint_as_float(k2.y << 16), k3 = __uint_as_float(k2.y & 0xffff0000u);
                    bsum += (r0 * k0 * rk.x + r1 * k1 * rk.y) + (r2f * k2f * rk.z + r3 * k3 * rk.w); }
            bsum += __shfl_xor(bsum, 32);
            asm volatile("" : "+v"(bsum));
#pragma unroll
            for (int it = 0; it < 2; ++it)
#pragma unroll
                for (int g4 = 0; g4 < 4; ++g4) { const int ch = h * 64 + 32 * it + 8 * g4 + 4 * hh; const size_t o = m * AW + ch;
                    const u32x2 v2 = *(const u32x2*)(B.VV + o), g2 = *(const u32x2*)(B.GG + o);
                    const f32x4 lg = *(const f32x4*)(lnx_g + ch), lb = *(const f32x4*)(lnx_b + ch);
                    const float vv[4] = {__uint_as_float(v2.x << 16), __uint_as_float(v2.x & 0xffff0000u), __uint_as_float(v2.y << 16), __uint_as_float(v2.y & 0xffff0000u)};
                    const float gg[4] = {__uint_as_float(g2.x << 16), __uint_as_float(g2.x & 0xffff0000u), __uint_as_float(g2.y << 16), __uint_as_float(g2.y & 0xffff0000u)};
                    float o4[4];
#pragma unroll
                    for (int i = 0; i < 4; ++i) { const float yn = (Y[it][4 * g4 + i] - mean) * rstd * lg[i] + lb[i]; o4[i] = (yn + bsum * vv[i]) * gg[i]; }
                    u32x2 w; w.x = pg8::cvt_pk_bf16(o4[0], o4[1]); w.y = pg8::cvt_pk_bf16(o4[2], o4[3]);
                    *(u32x2*)(B.YA + m * AW + ch) = w; }
        }
    }
}

__global__ void __launch_bounds__(NTHREADS, 2) mega(Args args) {
    extern __shared__ __attribute__((aligned(16))) unsigned char lds_raw[];
    Frame F; F.lds = (LAS unsigned char*)lds_raw;
    F.wave = __builtin_amdgcn_readfirstlane((int)(threadIdx.x >> 6));
    F.G = gridDim.x; { const int bx = blockIdx.x; F.vcu = (F.G % 8 == 0) ? (bx % 8) * (F.G / 8) + bx / 8 : bx; }
    unsigned char* ws = args.ws;
    unsigned* ctl = (unsigned*)(ws + WS_CTL);
    for (int u = F_TID; u < (LDS_BYTES - LDSCTL_OFF) / 4; u += NTHREADS) ((LAS unsigned*)(F.lds + LDSCTL_OFF))[u] = 0u;
    __syncthreads();
    XcdBarrier bar = xcd_barrier_post(ctl + CW_BAR + args.li * XCD_BAR_WORDS, (volatile LAS unsigned*)(F.lds + MISC_OFF) + 8);
    const int lo = args.ph_lo, hi = args.ph_hi;
#define IN(k) (lo <= (k) && (k) < hi)
#define SEAM(k) do { if (IN(k) && IN((k) + 1)) xcd_barrier(bar); } while (0)
    bf16* WIN = (bf16*)(ws + WS_WIN); bf16* WOA = (bf16*)(ws + WS_WOA); bf16* WOB = (bf16*)(ws + WS_WOB); bf16* WOUT = (bf16*)(ws + WS_WOUT);
    bf16* H1 = (bf16*)args.out;
    bf16* PA = (bf16*)(ws + WS_PA), *ZB = (bf16*)(ws + WS_ZB), *GT = (bf16*)(ws + WS_GT);

    if (IN(PH_P0)) {
        LAS float* scr = (LAS float*)(F.lds + F.wave * 16384);
        const int gw = F.vcu * NWAVES + F.wave, NGW = F.G * NWAVES;
        constexpr int I_IN = 16 * 153, I_OA = 8 * 32, I_OUT = 16 * 32, NITEMS = I_IN + 2 * I_OA + I_OUT;
        for (int it = gw; it < NITEMS; it += NGW) {
            int r = it;
            if (r < I_IN) { const int kb = r / 153, nb = r % 153; p0_transpose_item(args.in[2], 1024, IN_COLS, WIN, 1024, (32 * nb >= A_COLS) ? 224 : 0, scr, kb, nb, F_LANE); continue; } r -= I_IN;
            if (r < I_OA) { p0_transpose_item(args.in[15], 512, 1024, WOA, 512, 0, scr, r / 32, r % 32, F_LANE); continue; } r -= I_OA;
            if (r < I_OA) { p0_transpose_item(args.in[20], 512, 1024, WOB, 512, 0, scr, r / 32, r % 32, F_LANE); continue; } r -= I_OA;
            p0_transpose_item(args.in[21], 1024, 1024, WOUT, 1024, 0, scr, r / 32, r % 32, F_LANE);
        }
        for (int i = gw * 64 + F_LANE; i < 224 * 1024 / 8; i += NGW * 64) ((u32x4*)(WIN + (size_t)A_COLS * 1024))[i] = (u32x4){0u, 0u, 0u, 0u};
        const float* x = args.in[0]; const float* g1 = args.in[1];
        for (int m = gw; m < M; m += NGW) {
            const f32x4* xr = (const f32x4*)(x + (size_t)m * D) + F_LANE;
            f32x4 v[4]; float s = 0.f;
#pragma unroll
            for (int j = 0; j < 4; ++j) { v[j] = xr[64 * j]; s += (v[j].x * v[j].x + v[j].y * v[j].y) + (v[j].z * v[j].z + v[j].w * v[j].w); }
            const float rs = rsqrtf(wave_sum(s) * (1.f / D) + 1e-6f);
            u32x2* o8 = (u32x2*)(H1 + (size_t)m * D) + F_LANE;
#pragma unroll
            for (int j = 0; j < 4; ++j) { const f32x4 gg = *((const f32x4*)g1 + F_LANE + 64 * j);
                u32x2 w; w.x = pk2(v[j].x * rs * gg.x, v[j].y * rs * gg.y); w.y = pk2(v[j].z * rs * gg.z, v[j].w * rs * gg.w); o8[64 * j] = w; }
        }
    }
    SEAM(PH_P0);
    if (IN(PH_GEMM1)) {
        pg8::Gemm g{D, D, D}; pg8::StaticOrder S; S.init(H1, WIN, D, D, M, N1, F.G, (int)blockIdx.x);
        Epi1 E{PA, ZB, GT, args.in[3]};
        pg8::gemm_phase<Epi1, pg8::StaticOrder, true, true>(F.lds, g, S, E);
    }
    SEAM(PH_GEMM1);
    ScanBufs SB{(const bf16*)args.out, (const bf16*)((char*)args.out + 16 * MiB), (const bf16*)((char*)args.out + 32 * MiB), (const bf16*)((char*)args.out + 48 * MiB),
                (const bf16*)(ws + WS_LW), (const bf16*)(ws + WS_VV), (const bf16*)(ws + WS_GG), (bf16*)(ws + WS_PHIT), (bf16*)(ws + WS_QT), (float*)(ws + WS_LT), (float*)(ws + WS_YL),
                (bf16*)((char*)args.out + 16 * MiB), (bf16*)(ws + WS_YA)};
#ifndef NO_S1
    if (IN(PH_SCAN1)) scan_pass1(F, SB);
#endif
    SEAM(PH_SCAN1);
#ifndef NO_S2
    if (IN(PH_SCAN2)) scan_pass2(F, SB);
#endif
    SEAM(PH_SCAN2);
#ifndef NO_S3
    if (IN(PH_SCAN3)) scan_pass3(F, SB, args.in[12], args.in[13], args.in[14]);
#endif
    SEAM(PH_SCAN3);
    bf16* YB = (bf16*)(ws + WS_YB), *YA = (bf16*)(ws + WS_YA), *MIX = (bf16*)(ws + WS_MIX);
    float* X1 = args.out;
    if (IN(PH_MIX)) {
        pg8::Gemm g{AW, AW, AW}; MixOrder S{(const char*)YA, (const char*)YB, (const char*)WOA, (const char*)WOB, F.G, (int)blockIdx.x};
        EpiMix E{GT, MIX};
        pg8::gemm_phase<EpiMix, MixOrder, true, true>(F.lds, g, S, E);
    }
    SEAM(PH_MIX);
    if (IN(PH_WOUT)) {
        pg8::Gemm g{D, D, D}; pg8::StaticOrder S; S.init(MIX, WOUT, D, D, M, D, F.G, (int)blockIdx.x);
        EpiX1 E{args.in[0], X1};
        pg8::gemm_phase<EpiX1, pg8::StaticOrder, true, true>(F.lds, g, S, E);
    }
    SEAM(PH_WOUT);
    unsigned* cnt = ctl + CW_CNT;
    bf16* H2 = (bf16*)(ws + WS_H2M); bf16* HG = (bf16*)(ws + WS_HG); bf16* YE = (bf16*)(ws + WS_YE); bf16* ACT = (bf16*)(ws + WS_ACT); bf16* WGU = (bf16*)(ws + WS_WGU); bf16* WD = (bf16*)(ws + WS_WD);
    int2* SEL_E = (int2*)(ws + WS_SELE); float2* SEL_W = (float2*)(ws + WS_SELW); int2* SEL_P = (int2*)(ws + WS_SELP); int2* ROW = (int2*)(ws + WS_ROW);
    if (IN(PH_ROUTER)) {
        volatile LAS int* lcnt = (volatile LAS int*)(F.lds);
        const float* g2n = args.in[22]; const float* w_rg = args.in[23]; const float* b_rg = args.in[24]; const float* w_re = args.in[25]; const float* b_re = args.in[26];
        for (int mb = F.vcu; mb < M / 64; mb += F.G) {
            __syncthreads();
            if (F_TID < 64) lcnt[F_TID] = 0;
            __syncthreads();
            for (int i = 0; i < 8; ++i) { const int tl = F.wave * 8 + i, m = mb * 64 + tl;
                const f32x4* xr = (const f32x4*)(X1 + (size_t)m * D) + F_LANE;
                float h[16]; float sq = 0.f;
#pragma unroll
                for (int j = 0; j < 4; ++j) { const f32x4 v = xr[64 * j]; h[4 * j] = v.x; h[4 * j + 1] = v.y; h[4 * j + 2] = v.z; h[4 * j + 3] = v.w; sq += (v.x * v.x + v.y * v.y) + (v.z * v.z + v.w * v.w); }
                const float rs = rsqrtf(wave_sum(sq) * (1.f / D) + 1e-6f);
#pragma unroll
                for (int j = 0; j < 4; ++j) { const f32x4 gg = *((const f32x4*)g2n + F_LANE + 64 * j);
                    h[4 * j] *= rs * gg.x; h[4 * j + 1] *= rs * gg.y; h[4 * j + 2] *= rs * gg.z; h[4 * j + 3] *= rs * gg.w;
                    u32x2 w; w.x = pk2(h[4 * j], h[4 * j + 1]); w.y = pk2(h[4 * j + 2], h[4 * j + 3]); ((u32x2*)(H2 + (size_t)m * D))[F_LANE + 64 * j] = w; }
                float gl[4];
#pragma unroll
                for (int gi = 0; gi < 4; ++gi) gl[gi] = 0.f;
#pragma unroll
                for (int j = 0; j < 4; ++j)
#pragma unroll
                    for (int q = 0; q < 4; ++q) { const int c = 4 * F_LANE + 256 * j + q; const f32x4 wv = *(const f32x4*)(w_rg + c * 4); const float hv = h[4 * j + q];
                        gl[0] += hv * wv.x; gl[1] += hv * wv.y; gl[2] += hv * wv.z; gl[3] += hv * wv.w; }
#pragma unroll
                for (int gi = 0; gi < 4; ++gi) gl[gi] = wave_sum(gl[gi]) + b_rg[gi];
                int gs = 0; float gm = gl[0];
#pragma unroll
                for (int gi = 1; gi < 4; ++gi) if (gl[gi] > gm) { gm = gl[gi]; gs = gi; }
                float den = 0.f;
#pragma unroll
                for (int gi = 0; gi < 4; ++gi) den += expf(gl[gi] - gm);
                const float gp = 1.f / den;
                float el[8];
#pragma unroll
                for (int e = 0; e < 8; ++e) el[e] = 0.f;
#pragma unroll
                for (int j = 0; j < 4; ++j)
#pragma unroll
                    for (int q = 0; q < 4; ++q) { const int c = 4 * F_LANE + 256 * j + q; const float* wp = w_re + ((size_t)gs * D + c) * 8; const f32x4 w0 = *(const f32x4*)wp, w1 = *(const f32x4*)(wp + 4); const float hv = h[4 * j + q];
                        el[0] += hv * w0.x; el[1] += hv * w0.y; el[2] += hv * w0.z; el[3] += hv * w0.w; el[4] += hv * w1.x; el[5] += hv * w1.y; el[6] += hv * w1.z; el[7] += hv * w1.w; }
#pragma unroll
                for (int e = 0; e < 8; ++e) el[e] = wave_sum(el[e]) + b_re[gs * 8 + e];
                int i1 = 0; float m1 = el[0];
#pragma unroll
                for (int e = 1; e < 8; ++e) if (el[e] > m1) { m1 = el[e]; i1 = e; }
                int i2 = -1; float m2 = -INFINITY;
#pragma unroll
                for (int e = 0; e < 8; ++e) if (e != i1 && el[e] > m2) { m2 = el[e]; i2 = e; }
                const float w1 = 1.f / (1.f + expf(m2 - m1)), w2 = 1.f - w1;
                if (F_LANE == 0) { const int e1 = gs * 8 + i1, e2 = gs * 8 + i2;
                    SEL_E[m] = make_int2(e1, e2); SEL_W[m] = make_float2(w1 * gp, w2 * gp);
                    lcnt[64 + 2 * tl] = __hip_atomic_fetch_add((LAS int*)&lcnt[e1], 1, __ATOMIC_RELAXED, __HIP_MEMORY_SCOPE_WORKGROUP);
                    lcnt[64 + 2 * tl + 1] = __hip_atomic_fetch_add((LAS int*)&lcnt[e2], 1, __ATOMIC_RELAXED, __HIP_MEMORY_SCOPE_WORKGROUP);
                    lcnt[192 + 2 * tl] = e1; lcnt[192 + 2 * tl + 1] = e2; }
            }
            __syncthreads();
            if (F_TID < 32) lcnt[32 + F_TID] = (int)__hip_atomic_fetch_add(cnt + F_TID, (unsigned)lcnt[F_TID], __ATOMIC_RELAXED, __HIP_MEMORY_SCOPE_AGENT);
            __syncthreads();
            if (F_TID < 64) { const int m = mb * 64 + F_TID; const int e1 = lcnt[192 + 2 * F_TID], e2 = lcnt[192 + 2 * F_TID + 1];
                SEL_P[m] = make_int2(lcnt[32 + e1] + lcnt[64 + 2 * F_TID], lcnt[32 + e2] + lcnt[64 + 2 * F_TID + 1]); }
        }
        __syncthreads();
        LAS float* scr = (LAS float*)(F.lds + 4096 + F.wave * 12288);
        const int gw = F.vcu * NWAVES + F.wave, NGW = F.G * NWAVES;
        for (int it = gw; it < 3 * 4096; it += NGW) { const int which = it >> 12, r = it & 4095;
            if (which < 2) { const int e = r >> 7, kb = (r >> 3) & 15, nb = r & 7;
                p0_transpose_item(args.in[27 + which] + (size_t)e * 1024 * 256, 1024, 256, WGU + (size_t)e * 512 * 1024, 1024, ((32 * nb) >> 7) * 128 + which * 128, scr, kb, nb, F_LANE); }
            else { const int e = r >> 7, kb = (r >> 5) & 3, nb = r & 31;
                p0_transpose_item(args.in[29] + (size_t)e * 256 * 1024, 256, 1024, WD + (size_t)e * 1024 * 256, 256, 0, scr, kb, nb, F_LANE); } }
    }
    SEAM(PH_ROUTER);
    if (IN(PH_GATHER)) {
        moe_tables(F, cnt);
        LAS const int* tab = (LAS const int*)(F.lds + TAB_OFF);
        const int gw = F.vcu * NWAVES + F.wave, NGW = F.G * NWAVES;
        for (int m = gw; m < M; m += NGW) { const int2 se = SEL_E[m]; const int2 sp = SEL_P[m];
            const int r1 = tab[se.x] * 256 + sp.x, r2 = tab[se.y] * 256 + sp.y;
            const u32x4* src = (const u32x4*)(H2 + (size_t)m * D); const u32x4 a = src[F_LANE], b = src[F_LANE + 64];
            u32x4* d1 = (u32x4*)(HG + (size_t)r1 * D); u32x4* d2 = (u32x4*)(HG + (size_t)r2 * D);
            d1[F_LANE] = a; d1[F_LANE + 64] = b; d2[F_LANE] = a; d2[F_LANE + 64] = b;
            if (F_LANE == 0) ROW[m] = make_int2(r1, r2); }
    }
    SEAM(PH_GATHER);
    if (IN(PH_MOE1)) {
        moe_tables(F, cnt);
        LAS const int* tab = (LAS const int*)(F.lds + TAB_OFF);
        pg8::Gemm g{D, D, D}; MoeOrder S{(const char*)HG, (const char*)WGU, tab, tab[32], 2, F.G, (int)blockIdx.x, (size_t)256 * 1024 * 2, (size_t)512 * 1024 * 2, (size_t)256 * 1024 * 2};
        EpiAct E{ACT};
        pg8::gemm_phase<EpiAct, MoeOrder, true, true>(F.lds, g, S, E);
    }
    SEAM(PH_MOE1);
    if (IN(PH_MOE2)) {
        moe_tables(F, cnt);
        LAS const int* tab = (LAS const int*)(F.lds + TAB_OFF);
        pg8::Gemm g{256, 256, 256}; MoeOrder S{(const char*)ACT, (const char*)WD, tab, tab[32], 4, F.G, (int)blockIdx.x, (size_t)256 * 256 * 2, (size_t)1024 * 256 * 2, (size_t)256 * 256 * 2};
        EpiYE E{YE};
        pg8::gemm_phase<EpiYE, MoeOrder, true, true>(F.lds, g, S, E);
    }
    SEAM(PH_MOE2);
    if (IN(PH_FINAL)) {
        const int gw = F.vcu * NWAVES + F.wave, NGW = F.G * NWAVES; const float* fg = args.in[30];
        for (int m = gw; m < M; m += NGW) { const int2 rw = ROW[m]; const float2 sw = SEL_W[m];
            const f32x4* xr = (const f32x4*)(X1 + (size_t)m * D) + F_LANE; const u32x2* y1 = (const u32x2*)(YE + (size_t)rw.x * D) + F_LANE; const u32x2* y2 = (const u32x2*)(YE + (size_t)rw.y * D) + F_LANE;
            f32x4 v[4]; float sq = 0.f;
#pragma unroll
            for (int j = 0; j < 4; ++j) { const f32x4 xv = xr[64 * j]; const u32x2 a = y1[64 * j], b = y2[64 * j];
                v[j].x = xv.x + sw.x * __uint_as_float(a.x << 16) + sw.y * __uint_as_float(b.x << 16);
                v[j].y = xv.y + sw.x * __uint_as_float(a.x & 0xffff0000u) + sw.y * __uint_as_float(b.x & 0xffff0000u);
                v[j].z = xv.z + sw.x * __uint_as_float(a.y << 16) + sw.y * __uint_as_float(b.y << 16);
                v[j].w = xv.w + sw.x * __uint_as_float(a.y & 0xffff0000u) + sw.y * __uint_as_float(b.y & 0xffff0000u);
                sq += (v[j].x * v[j].x + v[j].y * v[j].y) + (v[j].z * v[j].z + v[j].w * v[j].w); }
            const float rs = rsqrtf(wave_sum(sq) * (1.f / D) + 1e-6f);
            f32x4* o = (f32x4*)(args.out + (size_t)m * D) + F_LANE;
#pragma unroll
            for (int j = 0; j < 4; ++j) { const f32x4 gg = *((const f32x4*)fg + F_LANE + 64 * j); o[64 * j] = (f32x4){v[j].x * rs * gg.x, v[j].y * rs * gg.y, v[j].z * rs * gg.z, v[j].w * rs * gg.w}; }
        }
    }
#undef IN
#undef SEAM
}
}

extern "C" void kernel_launch(void* const* d_in, const int* in_sizes, int n_in, void* d_out, int out_size, void* d_ws, size_t ws_size, hipStream_t stream) {
    auto F = [&](int i) { return (const float*)d_in[i]; };
    char* ws = (char*)d_ws; char* ob = (char*)d_out;
    bf16* H1 = (bf16*)ob;
    bf16* R = (bf16*)ob, *KK = (bf16*)(ob + 16 * MiB), *BV = (bf16*)(ob + 32 * MiB), *KM = (bf16*)(ob + 48 * MiB);
    bf16* PA = (bf16*)(ws + WS_PA), *ZB = (bf16*)(ws + WS_ZB), *GT = (bf16*)(ws + WS_GT), *LW = (bf16*)(ws + WS_LW), *VV = (bf16*)(ws + WS_VV), *GG = (bf16*)(ws + WS_GG);
    bf16* YB = (bf16*)(ws + WS_YB), *YA = (bf16*)(ws + WS_YA), *MIX = (bf16*)(ws + WS_MIX), *H2 = (bf16*)(ws + WS_H2);
    float* Y = (float*)(ws + WS_Y); float* X1 = (float*)(ws + WS_GT);
    int2* SEL_E = (int2*)(ws + WS_SEL); float2* SEL_W = (float2*)(ws + WS_SEL + 256 * 1024);
    static int grid = 0;
    if (grid == 0) {
        int dev = 0, cus = 0;
        if (hipGetDevice(&dev) != hipSuccess || hipDeviceGetAttribute(&cus, hipDeviceAttributeMultiprocessorCount, dev) != hipSuccess) { grid = -1; return; }
        if (hipFuncSetAttribute((const void*)mega, hipFuncAttributeMaxDynamicSharedMemorySize, LDS_BYTES) != hipSuccess) { grid = -1; return; }
        grid = cus;
    }
    if (grid < 0) return;
    (void)hipMemsetAsync(ws + WS_CTL, 0, CTL_ZERO_BYTES, stream);
    Args a{};
    for (int i = 0; i < 31; ++i) a.in[i] = (const float*)d_in[i];
    a.out = (float*)d_out; a.ws = (unsigned char*)d_ws;
    auto launch = [&](int lo, int hi, int li) { a.ph_lo = lo; a.ph_hi = hi; a.li = li; hipLaunchKernelGGL(mega, dim3(grid), dim3(NTHREADS), LDS_BYTES, stream, a); };
    launch(PH_P0, PH_PREP, 0);
    k_prep<<<M, 512, 0, stream>>>(PA, F(4), F(5), F(6), F(7), F(8), F(9), F(10), F(11), R, KK, BV, KM, LW, VV, GG);
    k_gmlp<<<BATCH * 16 * 4 * 2, 256, 0, stream>>>(ZB, F(16), F(17), F(18), F(19), YB);
    launch(PH_SCAN1, PH_END, 1);
}
```

```cpp
#include <hip/hip_runtime.h>
#include <stdint.h>
#include <math.h>

namespace {
typedef unsigned short bf16;
constexpr int D = 1024, BATCH = 8, T = 2048, M = BATCH * T;
constexpr int AW = 512;
constexpr int A_COLS = 1824, B_COLS = 1024, IN_COLS = 4896;
constexpr int PA_LD = 2048;
constexpr size_t MiB = 1u << 20;
constexpr size_t WS_PA = 16 * MiB, WS_ZB = 80 * MiB, WS_GT = 112 * MiB, WS_LW = 176 * MiB, WS_VV = 192 * MiB, WS_GG = 208 * MiB,
                 WS_YB = 224 * MiB, WS_YA = 240 * MiB, WS_Y = 16 * MiB  , WS_MIX = 48 * MiB, WS_H2 = 80 * MiB, WS_SEL = 15 * MiB;

__device__ __forceinline__ float bf2f(bf16 b) { return __uint_as_float(((unsigned)b) << 16); }
__device__ __forceinline__ bf16 f2bf(float f) { unsigned u = __float_as_uint(f); u += 0x7fffu + ((u >> 16) & 1u); return (bf16)(u >> 16); }
__device__ __forceinline__ float wave_sum(float v) {
#pragma unroll
    for (int o = 1; o < 64; o <<= 1) v += __shfl_xor(v, o);
    return v;
}
__device__ __forceinline__ float sigmoidf_(float x) { return 1.f / (1.f + expf(-x)); }

__global__ void __launch_bounds__(256) k_rms_bf16(const float* __restrict__ x, const float* __restrict__ g, bf16* __restrict__ out) {
    const int row = blockIdx.x * 4 + (threadIdx.x >> 6), lane = threadIdx.x & 63;
    const float4* xr = (const float4*)(x + (size_t)row * D) + lane;
    float4 v[4]; float s = 0.f;
#pragma unroll
    for (int j = 0; j < 4; ++j) { v[j] = xr[64 * j]; s += v[j].x * v[j].x + v[j].y * v[j].y + v[j].z * v[j].z + v[j].w * v[j].w; }
    s = wave_sum(s);
    const float rs = rsqrtf(s * (1.f / D) + 1e-6f);
#pragma unroll
    for (int j = 0; j < 4; ++j) { const int c = 4 * lane + 256 * j; bf16* o = out + (size_t)row * D + c;
        o[0] = f2bf(v[j].x * rs * g[c]); o[1] = f2bf(v[j].y * rs * g[c + 1]); o[2] = f2bf(v[j].z * rs * g[c + 2]); o[3] = f2bf(v[j].w * rs * g[c + 3]); }
}

__device__ __forceinline__ void ngemm_acc(const bf16* __restrict__ A, int lda, const float* __restrict__ W, int ldw, int K, int m0, int n, bool nok, float (&acc)[8], float* As) {
    __syncthreads();
    for (int idx = threadIdx.x; idx < 8 * K; idx += 256) { const int i = idx / K, k = idx - i * K; As[i * 1024 + k] = bf2f(A[(size_t)(m0 + i) * lda + k]); }
    __syncthreads();
    if (nok) {
        for (int k = 0; k < K; ++k) { const float w = W[(size_t)k * ldw + n];
#pragma unroll
            for (int i = 0; i < 8; ++i) acc[i] += As[i * 1024 + k] * w; }
    }
}

__global__ void __launch_bounds__(256) k_gemm1(const bf16* __restrict__ H1, const float* __restrict__ w_in, const float* __restrict__ b_gate, bf16* PA, bf16* ZB, bf16* GT) {
    __shared__ float As[8 * 1024];
    const int n = blockIdx.x * 256 + threadIdx.x, m0 = blockIdx.y * 8; const bool nok = n < IN_COLS;
    float acc[8] = {0, 0, 0, 0, 0, 0, 0, 0};
    ngemm_acc(H1, D, w_in, IN_COLS, D, m0, n, nok, acc, As);
    if (!nok) return;
#pragma unroll
    for (int i = 0; i < 8; ++i) { const size_t m = m0 + i; const float p = acc[i];
        if (n < A_COLS) PA[m * PA_LD + n] = f2bf(p);
        else if (n < A_COLS + B_COLS) ZB[m * 1024 + (n - A_COLS)] = f2bf(0.5f * p * (1.f + erff(p * 0.70710678118f)));
        else { const int c = n - A_COLS - B_COLS; GT[m * 2048 + c] = f2bf(sigmoidf_(p + b_gate[c])); } }
}

__global__ void __launch_bounds__(512) k_prep(const bf16* __restrict__ PA, const float* __restrict__ mu, const float* __restrict__ w0, const float* __restrict__ w2, const float* __restrict__ a0,
                                              const float* __restrict__ a2, const float* __restrict__ g2, const float* __restrict__ k_k, const float* __restrict__ k_a,
                                              bf16* R, bf16* KK, bf16* BV, bf16* KM, bf16* LW, bf16* VV, bf16* GG) {
    __shared__ float xs[288];
    const int m = blockIdx.x, t = m & (T - 1), c = threadIdx.x;
    const bf16* p = PA + (size_t)m * PA_LD; const bf16* pp = p - PA_LD;
    auto lerp = [&](int col) { const float cur = bf2f(p[col]); const float prev = t > 0 ? bf2f(pp[col]) : 0.f; return cur + mu[col] * (prev - cur); };
    const float r = lerp(c), k = lerp(512 + c), v = lerp(1024 + c);
    if (c < 288) { float xv = lerp(1536 + c); if (c < 64) xv = tanhf(xv); else if (c >= 128) xv = sigmoidf_(xv); xs[c] = xv; }
    __syncthreads();
    float wp = w0[c], ap = a0[c], gp = 0.f;
#pragma unroll 8
    for (int q = 0; q < 64; ++q) { wp += xs[q] * w2[q * 512 + c]; ap += xs[64 + q] * a2[q * 512 + c]; }
#pragma unroll 8
    for (int q = 0; q < 160; ++q) gp += xs[128 + q] * g2[q * 512 + c];
    const float lw = -0.60653066f * sigmoidf_(wp);
    const float a = sigmoidf_(ap);
    float kk = k * k_k[c];
    const float ss = wave_sum(kk * kk);
    kk = kk / fmaxf(sqrtf(ss), 1e-12f);
    const float km = k * (1.f + (a - 1.f) * k_a[c]);
    const size_t o = (size_t)m * AW + c;
    R[o] = f2bf(r); KK[o] = f2bf(kk); BV[o] = f2bf(kk * a); KM[o] = f2bf(km); LW[o] = f2bf(lw); VV[o] = f2bf(v); GG[o] = f2bf(gp);
}

__global__ void __launch_bounds__(256) k_gmlp(const bf16* __restrict__ ZB, const float* __restrict__ lnv_g, const float* __restrict__ lnv_b, const float* __restrict__ w_s, const float* __restrict__ b_s, bf16* YB) {
    __shared__ float vn[128][64];
    __shared__ float s_mean[128], s_rstd[128];
    const int dh = blockIdx.x & 1, g = (blockIdx.x >> 1) & 3, bc = blockIdx.x >> 3;
    const int wave = threadIdx.x >> 6, lane = threadIdx.x & 63; const size_t m0 = (size_t)bc * 128;
    for (int s = wave * 32; s < wave * 32 + 32; ++s) { const bf16* vr = ZB + (m0 + s) * 1024 + 512;
        float x[8]; float sum = 0.f;
#pragma unroll
        for (int j = 0; j < 8; ++j) { x[j] = bf2f(vr[lane + 64 * j]); sum += x[j]; }
        const float mean = wave_sum(sum) * (1.f / 512.f); float q = 0.f;
#pragma unroll
        for (int j = 0; j < 8; ++j) { const float d = x[j] - mean; q += d * d; }
        const float var = wave_sum(q) * (1.f / 512.f);
        if (lane == 0) { s_mean[s] = mean; s_rstd[s] = rsqrtf(var + 1e-5f); } }
    __syncthreads();
    const int ch0 = g * 128 + dh * 64;
    for (int idx = threadIdx.x; idx < 128 * 64; idx += 256) { const int s = idx >> 6, dd = idx & 63; const int ch = ch0 + dd;
        vn[s][dd] = (bf2f(ZB[(m0 + s) * 1024 + 512 + ch]) - s_mean[s]) * s_rstd[s] * lnv_g[ch] + lnv_b[ch]; }
    __syncthreads();
    const int dd = threadIdx.x & 63, tq = threadIdx.x >> 6;
    for (int t = tq * 32; t < tq * 32 + 32; ++t) { const float* wr = w_s + ((size_t)g * 128 + t) * 128; float acc = 0.f;
        for (int s = 0; s <= t; ++s) acc += wr[s] * vn[s][dd];
        const float sv = acc + b_s[g * 128 + t]; const size_t m = m0 + t; const float u = bf2f(ZB[m * 1024 + ch0 + dd]);
        YB[m * AW + ch0 + dd] = f2bf(u * sv); }
}

__global__ void __launch_bounds__(64) k_wkv_naive(const bf16* __restrict__ R, const bf16* __restrict__ KK, const bf16* __restrict__ BV, const bf16* __restrict__ KM, const bf16* __restrict__ LW,
                                                  const bf16* __restrict__ VV, float* Y) {
    __shared__ float va[64], vb[64], vk[64], vr[64], vd[64];
    const int b = blockIdx.x >> 3, h = blockIdx.x & 7, lane = threadIdx.x;
    float s[64];
#pragma unroll
    for (int j = 0; j < 64; ++j) s[j] = 0.f;
    for (int t = 0; t < T; ++t) { const size_t o = ((size_t)b * T + t) * AW + h * 64 + lane;
        va[lane] = -bf2f(KK[o]); vb[lane] = bf2f(BV[o]); vk[lane] = bf2f(KM[o]); vr[lane] = bf2f(R[o]); vd[lane] = expf(bf2f(LW[o]));
        const float v = bf2f(VV[o]);
        __syncthreads();
        float sa = 0.f;
#pragma unroll
        for (int j = 0; j < 64; ++j) sa += s[j] * va[j];
        float y = 0.f;
#pragma unroll
        for (int j = 0; j < 64; ++j) { s[j] = s[j] * vd[j] + sa * vb[j] + v * vk[j]; y += s[j] * vr[j]; }
        Y[o] = y;
        __syncthreads(); }
}

__global__ void __launch_bounds__(512) k_post(const float* __restrict__ Y, const bf16* __restrict__ R, const bf16* __restrict__ KM, const bf16* __restrict__ VV, const bf16* __restrict__ GG,
                                              const float* __restrict__ r_k, const float* __restrict__ lnx_g, const float* __restrict__ lnx_b, bf16* YA) {
    const int c = threadIdx.x; const size_t o = (size_t)blockIdx.x * AW + c;
    const float y = Y[o]; const float mean = wave_sum(y) * (1.f / 64.f); const float d = y - mean; const float var = wave_sum(d * d) * (1.f / 64.f);
    const float yn = d * rsqrtf(var + 64e-5f) * lnx_g[c] + lnx_b[c];
    const float r = bf2f(R[o]), km = bf2f(KM[o]), v = bf2f(VV[o]), g = bf2f(GG[o]);
    const float bonus = wave_sum(r * km * r_k[c]) * v;
    YA[o] = f2bf((yn + bonus) * g);
}

__global__ void __launch_bounds__(256) k_mix(const bf16* __restrict__ YA, const bf16* __restrict__ YB, const bf16* __restrict__ GT, const float* __restrict__ w_oA, const float* __restrict__ w_oB, bf16* MIX) {
    __shared__ float As[8 * 1024];
    const int n = blockIdx.x * 256 + threadIdx.x, m0 = blockIdx.y * 8;
    float a1[8] = {0, 0, 0, 0, 0, 0, 0, 0}, a2[8] = {0, 0, 0, 0, 0, 0, 0, 0};
    ngemm_acc(YA, AW, w_oA, D, AW, m0, n, true, a1, As);
    ngemm_acc(YB, AW, w_oB, D, AW, m0, n, true, a2, As);
#pragma unroll
    for (int i = 0; i < 8; ++i) { const size_t m = m0 + i; MIX[m * D + n] = f2bf(bf2f(GT[m * 2048 + n]) * a1[i] + bf2f(GT[m * 2048 + 1024 + n]) * a2[i]); }
}
__global__ void __launch_bounds__(256) k_wout(const bf16* __restrict__ MIX, const float* __restrict__ w_out, const float* __restrict__ x, float* X1) {
    __shared__ float As[8 * 1024];
    const int n = blockIdx.x * 256 + threadIdx.x, m0 = blockIdx.y * 8;
    float acc[8] = {0, 0, 0, 0, 0, 0, 0, 0};
    ngemm_acc(MIX, D, w_out, D, D, m0, n, true, acc, As);
#pragma unroll
    for (int i = 0; i < 8; ++i) { const size_t m = m0 + i; X1[m * D + n] = x[m * D + n] + acc[i]; }
}

__global__ void __launch_bounds__(256) k_router(const float* __restrict__ X1, const float* __restrict__ g2n, const float* __restrict__ w_rg, const float* __restrict__ b_rg, const float* __restrict__ w_re,
                                                const float* __restrict__ b_re, bf16* H2, int2* SEL_E, float2* SEL_W) {
    const int m = blockIdx.x * 4 + (threadIdx.x >> 6), lane = threadIdx.x & 63;
    const float4* xr = (const float4*)(X1 + (size_t)m * D) + lane;
    float h[16]; float s = 0.f;
#pragma unroll
    for (int j = 0; j < 4; ++j) { const float4 v = xr[64 * j]; h[4 * j] = v.x; h[4 * j + 1] = v.y; h[4 * j + 2] = v.z; h[4 * j + 3] = v.w; s += v.x * v.x + v.y * v.y + v.z * v.z + v.w * v.w; }
    const float rs = rsqrtf(wave_sum(s) * (1.f / D) + 1e-6f);
#pragma unroll
    for (int j = 0; j < 4; ++j)
#pragma unroll
        for (int i = 0; i < 4; ++i) { const int c = 4 * lane + 256 * j + i; h[4 * j + i] *= rs * g2n[c]; H2[(size_t)m * D + c] = f2bf(h[4 * j + i]); }
    float gl[4];
#pragma unroll
    for (int gi = 0; gi < 4; ++gi) { float p = 0.f;
#pragma unroll
        for (int j = 0; j < 4; ++j)
#pragma unroll
            for (int i = 0; i < 4; ++i) { const int c = 4 * lane + 256 * j + i; p += h[4 * j + i] * w_rg[c * 4 + gi]; }
        gl[gi] = wave_sum(p) + b_rg[gi]; }
    int gs = 0; float gm = gl[0];
#pragma unroll
    for (int gi = 1; gi < 4; ++gi) if (gl[gi] > gm) { gm = gl[gi]; gs = gi; }
    float den = 0.f;
#pragma unroll
    for (int gi = 0; gi < 4; ++gi) den += expf(gl[gi] - gm);
    const float gp = 1.f / den;
    float el[8];
#pragma unroll
    for (int e = 0; e < 8; ++e) { float p = 0.f;
#pragma unroll
        for (int j = 0; j < 4; ++j)
#pragma unroll
            for (int i = 0; i < 4; ++i) { const int c = 4 * lane + 256 * j + i; p += h[4 * j + i] * w_re[((size_t)gs * D + c) * 8 + e]; }
        el[e] = wave_sum(p) + b_re[gs * 8 + e]; }
    int i1 = 0; float m1 = el[0];
#pragma unroll
    for (int e = 1; e < 8; ++e) if (el[e] > m1) { m1 = el[e]; i1 = e; }
    int i2 = -1; float m2 = -INFINITY;
#pragma unroll
    for (int e = 0; e < 8; ++e) if (e != i1 && el[e] > m2) { m2 = el[e]; i2 = e; }
    const float w1 = 1.f / (1.f + expf(m2 - m1)), w2 = 1.f - w1;
    if (lane == 0) { SEL_E[m] = make_int2(gs * 8 + i1, gs * 8 + i2); SEL_W[m] = make_float2(w1 * gp, w2 * gp); }
}

__global__ void __launch_bounds__(256) k_moe_final(const float* __restrict__ X1, const bf16* __restrict__ H2, const int2* __restrict__ SEL_E, const float2* __restrict__ SEL_W, const float* __restrict__ Wg,
                                                   const float* __restrict__ Wu, const float* __restrict__ Wd, const float* __restrict__ fg, float* out) {
    __shared__ float hs[1024], act[256], red[4];
    const int m = blockIdx.x, tid = threadIdx.x;
    for (int i = tid; i < 1024; i += 256) hs[i] = bf2f(H2[(size_t)m * D + i]);
    __syncthreads();
    const int2 se = SEL_E[m]; const float2 sw = SEL_W[m];
    float o[4] = {0, 0, 0, 0};
    for (int s = 0; s < 2; ++s) { const int e = s ? se.y : se.x; const float w = s ? sw.y : sw.x;
        const float* wg = Wg + (size_t)e * 1024 * 256 + tid; const float* wu = Wu + (size_t)e * 1024 * 256 + tid;
        float ga = 0.f, ua = 0.f;
        for (int k = 0; k < 1024; ++k) { ga += hs[k] * wg[(size_t)k * 256]; ua += hs[k] * wu[(size_t)k * 256]; }
        act[tid] = ga / (1.f + expf(-ga)) * ua * w;
        __syncthreads();
        const float* wd = Wd + (size_t)e * 256 * 1024 + tid;
        for (int j = 0; j < 256; ++j) { const float a = act[j];
#pragma unroll
            for (int i = 0; i < 4; ++i) o[i] += a * wd[(size_t)j * 1024 + 256 * i]; }
        __syncthreads(); }
    float x2[4]; float ss = 0.f;
#pragma unroll
    for (int i = 0; i < 4; ++i) { x2[i] = X1[(size_t)m * D + tid + 256 * i] + o[i]; ss += x2[i] * x2[i]; }
    ss = wave_sum(ss);
    if ((tid & 63) == 0) red[tid >> 6] = ss;
    __syncthreads();
    const float rs = rsqrtf((red[0] + red[1] + red[2] + red[3]) * (1.f / D) + 1e-6f);
    __syncthreads();
#pragma unroll
    for (int i = 0; i < 4; ++i) out[(size_t)m * D + tid + 256 * i] = x2[i] * rs * fg[tid + 256 * i];
}

#define LAS __attribute__((address_space(3)))
#define GAS __attribute__((address_space(1)))
typedef short bf16x8 __attribute__((ext_vector_type(8)));
typedef float f32x4 __attribute__((ext_vector_type(4)));
typedef float f32x2 __attribute__((ext_vector_type(2)));
typedef unsigned u32x4 __attribute__((ext_vector_type(4)));
typedef unsigned u32x2 __attribute__((ext_vector_type(2)));

namespace pg8 {
constexpr int BM = 256, BK = 64, HALF = 128, HTB = HALF * BK * 2, STAGE_BYTES = 8 * HTB, NXCD = 8, WGM = 8;
__device__ __forceinline__ int lds_byte(int r, int c) { const int st = (r >> 4) * 2 + (c >> 5), rr = r & 15, cc = c & 31, ob = rr * 64 + cc * 2; return st * 1024 + (ob ^ (((ob >> 9) & 1) << 5)); }
__device__ __forceinline__ void stage_rc(int b, int& R, int& C) { const int st = b / 1024, sb = b % 1024, swz = sb ^ (((sb >> 9) & 1) << 5); R = (st >> 1) * 16 + swz / 64; C = (st & 1) * 32 + (swz % 64) / 2; }
__device__ __forceinline__ int perm32(int rho) { const int n = rho >> 4, i = rho & 15; return 8 * (i >> 2) + 4 * n + (i & 3); }

struct Unit { int pm, pn; const char* A; const char* B; int aux; };
struct Gemm { int lda, ldb, K; };

__device__ __forceinline__ void tile_order(int L, int nM, int nN, int& pm, int& pn) {
    const int nwg = nM * nN; int wgid = L; { const int q = nwg / NXCD, r = nwg % NXCD, xcd = wgid % NXCD, off = wgid / NXCD; wgid = (xcd < r ? xcd * (q + 1) : r * (q + 1) + (xcd - r) * q) + off; }
    const int nig = WGM * nN, gid = wgid / nig, fm = gid * WGM, gsz = (nM - fm) < WGM ? (nM - fm) : WGM;
    pm = fm + ((wgid % nig) % gsz); pn = (wgid % nig) / gsz;
}
struct StaticOrder {
    const char* A; const char* B; int lda, ldb, nM, nN, nwg, G, c;
    __device__ void init(const void* A_, const void* B_, int lda_, int ldb_, int M, int N, int G_, int c_) { A = (const char*)A_; B = (const char*)B_; lda = lda_; ldb = ldb_; nM = M / BM; nN = N / BM; nwg = nM * nN; G = G_; c = c_; }
    __device__ __forceinline__ bool next(int i, Unit& u) const {
        const int L = i * G + c; if (L >= nwg) return false;
        tile_order(L, nM, nN, u.pm, u.pn);
        u.A = A + (size_t)u.pm * BM * lda * 2; u.B = B + (size_t)u.pn * BM * ldb * 2; u.aux = 0; return true;
    }
};

__device__ __forceinline__ unsigned cvt_pk_bf16(float lo, float hi) { unsigned r; asm volatile("v_cvt_pk_bf16_f32 %0, %1, %2" : "=v"(r) : "v"(lo), "v"(hi)); return r; }
__device__ __forceinline__ f32x2 gelu_pk(f32x2 v) {
    const f32x2 av = __builtin_elementwise_abs(v), d = av * 0.2316418882f + 1.0f;
    f32x2 t; t.x = __builtin_amdgcn_rcpf(d.x); t.y = __builtin_amdgcn_rcpf(d.y);
    f32x2 q = t * 0.5307027145f + (-0.7265760135f); q = q * t + 0.7107068705f; q = q * t + (-0.142248368f); q = q * t + 0.127414796f; q = q * t;
    const f32x2 s = (v * v) * (-0.72134752044f);
    f32x2 e; e.x = __builtin_amdgcn_exp2f(s.x); e.y = __builtin_amdgcn_exp2f(s.y);
    const f32x2 m = v * (q * e), r = v - m;
    f32x2 o; o.x = v.x < 0.f ? m.x : r.x; o.y = v.y < 0.f ? m.y : r.y; return o;
}
__device__ __forceinline__ float fast_sigmoid(float x) { return __builtin_amdgcn_rcpf(1.0f + __builtin_amdgcn_exp2f(-1.4426950408889634f * x)); }

template <class Epi, class Sched, bool ALIGN_EPI, bool SP2>
__device__ __forceinline__ void gemm_phase(LAS unsigned char* lds, const Gemm g, const Sched& S, const Epi& E) {
    const int tid = threadIdx.x, wid = __builtin_amdgcn_readfirstlane(tid >> 6), lane = tid & 63, wr = wid >> 2, wc = wid & 3, fr = lane & 15, fq = lane >> 4;
    const int K = g.K, nt = K / BK;
    unsigned voffA[2], voffB[2];
#pragma unroll
    for (int i = 0; i < 2; ++i) { int R, C; stage_rc(tid * 16 + i * 8192, R, C); const int Rb = Epi::PERM ? ((R & ~31) + perm32(R & 31)) : R;
        voffA[i] = (unsigned)(R * g.lda + C) * 2u; voffB[i] = (unsigned)(Rb * g.ldb + C) * 2u; }
    const size_t kstep = (size_t)(BK * 2);
    const size_t hstepA = (size_t)HALF * g.lda * 2, hstepB = (size_t)HALF * g.ldb * 2;
    const unsigned ldsw = (unsigned)wid * 1024u;
    const int aoff = lds_byte(wr * 64 + fr, fq * 8), boff = lds_byte(wc * 32 + fr, fq * 8);
#define PG8_SA(b, h) (((b) * 2 + (h)) * HTB)
#define PG8_SB(b, h) ((4 + (b) * 2 + (h)) * HTB)
#define PG8_STAGE(bufoff, gbase, voff) do { _Pragma("unroll") for (int _i = 0; _i < 2; ++_i) \
        __builtin_amdgcn_global_load_lds((const unsigned*)((const char*)(gbase) + (voff)[_i]), (LAS unsigned*)(lds + (bufoff) + ldsw + _i * 8192), 16, 0, 0); } while (0)
#define PG8_LDA(dst, b, h) do { _Pragma("unroll") for (int m = 0; m < 4; ++m) _Pragma("unroll") for (int k = 0; k < 2; ++k) dst[m][k] = *(const LAS bf16x8*)(lds + PG8_SA(b, h) + aoff + m * 2048 + k * 1024); } while (0)
#define PG8_LDB(dst, b, h) do { _Pragma("unroll") for (int n = 0; n < 2; ++n) _Pragma("unroll") for (int k = 0; k < 2; ++k) dst[n][k] = *(const LAS bf16x8*)(lds + PG8_SB(b, h) + boff + n * 2048 + k * 1024); } while (0)
#define PG8_MMA(ai, bj, At, Bt) do { __builtin_amdgcn_s_setprio(1); _Pragma("unroll") for (int m = 0; m < 4; ++m) _Pragma("unroll") for (int n = 0; n < 2; ++n) _Pragma("unroll") for (int k = 0; k < 2; ++k) \
        acc[ai][bj][m][n] = __builtin_amdgcn_mfma_f32_16x16x32_bf16(Bt[n][k], At[m][k], acc[ai][bj][m][n], 0, 0, 0); __builtin_amdgcn_s_setprio(0); } while (0)
#define PG8_WAIT_V(n) asm volatile("s_waitcnt vmcnt(" #n ")" ::: "memory")
#define PG8_WAIT_L(n) asm volatile("s_waitcnt lgkmcnt(" #n ")" ::: "memory")
#define PG8_BAR __builtin_amdgcn_s_barrier()
#define PG8_SCHED __builtin_amdgcn_sched_barrier(0)
    Unit cur, nxt; int ui = 0;
    if (!S.next(0, cur)) return;
    f32x4 acc[2][2][4][2];
#pragma unroll
    for (int a = 0; a < 2; ++a)
#pragma unroll
        for (int b = 0; b < 2; ++b)
#pragma unroll
            for (int m = 0; m < 4; ++m)
#pragma unroll
                for (int n = 0; n < 2; ++n) acc[a][b][m][n] = (f32x4){0.f, 0.f, 0.f, 0.f};
    bf16x8 At[4][2], B0[2][2], B1[2][2];
    const char* cA = cur.A; const char* cB = cur.B;
    if constexpr (SP2) {
        PG8_STAGE(PG8_SB(0, 0), cB, voffB); PG8_STAGE(PG8_SB(0, 1), cB + hstepB, voffB); PG8_STAGE(PG8_SA(0, 0), cA, voffA); PG8_STAGE(PG8_SA(0, 1), cA + hstepA, voffA);
        if (wr == 1) PG8_BAR;
        PG8_WAIT_V(2); PG8_BAR;
        PG8_STAGE(PG8_SB(1, 0), cB + kstep, voffB); PG8_STAGE(PG8_SA(1, 0), cA + kstep, voffA); PG8_STAGE(PG8_SB(1, 1), cB + hstepB + kstep, voffB);
        PG8_WAIT_V(6); PG8_BAR;
    } else {
        PG8_STAGE(PG8_SB(0, 0), cB, voffB); PG8_STAGE(PG8_SA(0, 0), cA, voffA); PG8_STAGE(PG8_SB(0, 1), cB + hstepB, voffB); PG8_STAGE(PG8_SA(0, 1), cA + hstepA, voffA);
        if (wr == 1) PG8_BAR;
        PG8_WAIT_V(4); PG8_BAR;
        PG8_STAGE(PG8_SB(1, 0), cB + kstep, voffB); PG8_STAGE(PG8_SA(1, 0), cA + kstep, voffA); PG8_STAGE(PG8_SB(1, 1), cB + hstepB + kstep, voffB);
        PG8_WAIT_V(6); PG8_BAR;
    }
    for (;;) {
        const bool has_next = S.next(ui + 1, nxt);
        const char* nA = has_next ? nxt.A : cA; const char* nB = has_next ? nxt.B : cB;
        for (int t = 0; t < nt; t += 2) {
            const bool last = (t == nt - 2);
            const char* a1 = cA + (size_t)(t + 1) * kstep;
            const char* a2 = last ? nA : cA + (size_t)(t + 2) * kstep; const char* b2 = last ? nB : cB + (size_t)(t + 2) * kstep;
            const char* a3 = a2 + kstep; const char* b3 = b2 + kstep;
            if constexpr (SP2) {
            PG8_LDB(B0, 0, 0); PG8_LDB(B1, 0, 1); PG8_SCHED; PG8_LDA(At, 0, 0); PG8_STAGE(PG8_SA(1, 1), a1 + hstepA, voffA);
            PG8_WAIT_V(8); PG8_WAIT_L(0); PG8_BAR; PG8_MMA(0, 0, At, B0); PG8_MMA(0, 1, At, B1); PG8_BAR; PG8_SCHED;
            PG8_LDA(At, 0, 1); PG8_STAGE(PG8_SB(0, 0), b2, voffB); PG8_STAGE(PG8_SB(0, 1), b2 + hstepB, voffB); PG8_STAGE(PG8_SA(0, 0), a2, voffA);
            PG8_WAIT_V(8); PG8_WAIT_L(0); PG8_BAR; PG8_MMA(1, 0, At, B0); PG8_MMA(1, 1, At, B1); PG8_BAR; PG8_SCHED;
            PG8_LDB(B0, 1, 0); PG8_LDB(B1, 1, 1); PG8_SCHED; PG8_LDA(At, 1, 0); PG8_STAGE(PG8_SA(0, 1), a2 + hstepA, voffA);
            PG8_WAIT_V(8); PG8_WAIT_L(0); PG8_BAR; PG8_MMA(0, 0, At, B0); PG8_MMA(0, 1, At, B1); PG8_BAR; PG8_SCHED;
            PG8_LDA(At, 1, 1); PG8_STAGE(PG8_SB(1, 0), b3, voffB); PG8_STAGE(PG8_SB(1, 1), b3 + hstepB, voffB); PG8_STAGE(PG8_SA(1, 0), a3, voffA);
            PG8_WAIT_V(8); PG8_WAIT_L(0); PG8_BAR; PG8_MMA(1, 0, At, B0); PG8_MMA(1, 1, At, B1); PG8_BAR; PG8_SCHED;
            } else {
            PG8_LDB(B0, 0, 0); PG8_SCHED; PG8_LDA(At, 0, 0); PG8_STAGE(PG8_SA(1, 1), a1 + hstepA, voffA);
            PG8_WAIT_L(8); PG8_BAR; PG8_WAIT_L(0); PG8_MMA(0, 0, At, B0); PG8_BAR; PG8_SCHED;
            PG8_LDB(B1, 0, 1); PG8_STAGE(PG8_SB(0, 0), b2, voffB);
            PG8_BAR; PG8_WAIT_L(0); PG8_MMA(0, 1, At, B1); PG8_BAR;
            PG8_LDA(At, 0, 1); PG8_STAGE(PG8_SA(0, 0), a2, voffA);
            PG8_BAR; PG8_WAIT_L(0); PG8_MMA(1, 0, At, B0); PG8_BAR; PG8_SCHED;
            PG8_STAGE(PG8_SB(0, 1), b2 + hstepB, voffB);
            PG8_WAIT_V(6); PG8_BAR; PG8_MMA(1, 1, At, B1); PG8_BAR;
            PG8_LDB(B0, 1, 0); PG8_SCHED; PG8_LDA(At, 1, 0); PG8_STAGE(PG8_SA(0, 1), a2 + hstepA, voffA);
            PG8_WAIT_L(8); PG8_BAR; PG8_WAIT_L(0); PG8_MMA(0, 0, At, B0); PG8_BAR; PG8_SCHED;
            PG8_LDB(B1, 1, 1); PG8_STAGE(PG8_SB(1, 0), b3, voffB);
            PG8_BAR; PG8_WAIT_L(0); PG8_MMA(0, 1, At, B1); PG8_BAR;
            PG8_LDA(At, 1, 1); PG8_STAGE(PG8_SA(1, 0), a3, voffA);
            PG8_BAR; PG8_WAIT_L(0); PG8_MMA(1, 0, At, B0); PG8_BAR; PG8_SCHED;
            PG8_STAGE(PG8_SB(1, 1), b3 + hstepB, voffB);
            PG8_WAIT_V(6); PG8_BAR; PG8_MMA(1, 1, At, B1); PG8_BAR;
            }
        }
        if constexpr (ALIGN_EPI) { if (wr == 0) PG8_BAR; }
        int l2 = lane; asm volatile("" : "+v"(l2));
        const bool keep = E(acc, cur, wr, wc, l2 & 15, l2 >> 4);
        if (!has_next) break;
        if (!keep) {
#pragma unroll
        for (int a = 0; a < 2; ++a)
#pragma unroll
            for (int b = 0; b < 2; ++b)
#pragma unroll
                for (int m = 0; m < 4; ++m)
#pragma unroll
                    for (int n = 0; n < 2; ++n) acc[a][b][m][n] = (f32x4){0.f, 0.f, 0.f, 0.f};
        }
        cur = nxt; cA = nA; cB = nB; ++ui;
        if constexpr (ALIGN_EPI) { if (wr == 1) PG8_BAR; }
    }
    PG8_WAIT_V(0);
    if constexpr (!ALIGN_EPI) { if (wr == 0) PG8_BAR; }
    PG8_BAR;
#undef PG8_SA
#undef PG8_SB
#undef PG8_STAGE
#undef PG8_LDA
#undef PG8_LDB
#undef PG8_MMA
#undef PG8_WAIT_V
#undef PG8_WAIT_L
#undef PG8_BAR
#undef PG8_SCHED
}
}

#define XB_TMO      128
#define XB_XCNT(j)  (256  + 64 * (j))
#define XB_XSUB(j)  (1280 + 64 * (j))
#define XB_XGEN(j)  (2304 + 64 * (j))
#define XB_TOP      3328
#define XB_TOPGEN   3392
#define XCD_BAR_WORDS 3456
#define XB_SPIN_CAP (1u << 20)
__device__ __forceinline__ unsigned xb_ld(unsigned* p)              { return __hip_atomic_load(p, __ATOMIC_RELAXED, __HIP_MEMORY_SCOPE_AGENT); }
__device__ __forceinline__ unsigned xb_add(unsigned* p, unsigned v) { return __hip_atomic_fetch_add(p, v, __ATOMIC_RELAXED, __HIP_MEMORY_SCOPE_AGENT); }
__device__ __forceinline__ unsigned xb_xcc_id() { return (unsigned)__builtin_amdgcn_s_getreg((3 << 11) | 20) & 0xFu; }
#define XB_SPIN(cond, bar) do { unsigned _sp = 0; while (cond) { __builtin_amdgcn_s_sleep(1); \
    if ((++_sp & 255u) == 0u) { if (xb_ld(&(bar)[XB_TMO])) break; if (_sp > XB_SPIN_CAP) { atomicAdd(&(bar)[XB_TMO], 1u); break; } } } } while (0)
struct XcdBarrier { unsigned* bar; unsigned x; volatile LAS unsigned* st; };
__device__ __forceinline__ XcdBarrier xcd_barrier_post(unsigned* bar, volatile LAS unsigned* st) {
    XcdBarrier b; b.bar = bar; b.x = xb_xcc_id(); b.st = st;
    if (threadIdx.x == 0) (void)xb_add(&bar[XB_XCNT(b.x)], 1u);
    return b;
}
__device__ __forceinline__ void xcd_barrier_complete(unsigned* bar, unsigned x, unsigned& nloc, unsigned& nx) {
    const unsigned G = gridDim.x * gridDim.y * gridDim.z;
    unsigned sum, cnt, mine, sp = 0u;
    for (;;) {
        sum = 0u; cnt = 0u; mine = 0u;
#pragma unroll
        for (unsigned j = 0; j < 16; ++j) { const unsigned c = xb_ld(&bar[XB_XCNT(j)]); sum += c; cnt += (c > 0u) ? 1u : 0u; mine = (j == x) ? c : mine; }
        if (sum == G) break;
        __builtin_amdgcn_s_sleep(1);
        if ((++sp & 255u) == 0u) { if (xb_ld(&bar[XB_TMO])) break; if (sp > XB_SPIN_CAP) { atomicAdd(&bar[XB_TMO], 1u); break; } }
    }
    nloc = mine > 0u ? mine : 1u; nx = cnt > 0u ? cnt : 1u;
}
__device__ __forceinline__ void xcd_barrier(const XcdBarrier& b) {
    asm volatile("s_waitcnt vmcnt(0)" ::: "memory");
    __syncthreads();
    if (threadIdx.x == 0) {
        unsigned* bar = b.bar;
        __builtin_amdgcn_s_waitcnt(0);
        unsigned nloc = b.st[0], nx = b.st[1];
        if (nloc == 0u) { xcd_barrier_complete(bar, b.x, nloc, nx); b.st[0] = nloc; b.st[1] = nx; }
        const unsigned old = xb_add(&bar[XB_XSUB(b.x)], 1u);
        const unsigned gen = old / nloc;
        if (old + 1u == (gen + 1u) * nloc) {
            __builtin_amdgcn_fence(__ATOMIC_RELEASE, "agent");
            asm volatile("s_waitcnt vmcnt(0)" ::: "memory");
            const unsigned og = xb_add(&bar[XB_TOP], 1u);
            const unsigned tg = og / nx;
            if (og + 1u == (tg + 1u) * nx) xb_add(&bar[XB_TOPGEN], 1u);
            else XB_SPIN(xb_ld(&bar[XB_TOPGEN]) == tg, bar);
            __builtin_amdgcn_fence(__ATOMIC_ACQUIRE, "agent");
            xb_add(&bar[XB_XGEN(b.x)], 1u);
            asm volatile("s_waitcnt vmcnt(0)" ::: "memory");
        } else {
            XB_SPIN(xb_ld(&bar[XB_XGEN(b.x)]) == gen, bar);
            __builtin_amdgcn_fence(__ATOMIC_ACQUIRE, "agent");
            asm volatile("s_waitcnt vmcnt(0)" ::: "memory");
        }
    }
    __syncthreads();
}

constexpr int NWAVES = 8, NTHREADS = 512;
constexpr int RING_BYTES = 131072, LDSCTL_OFF = RING_BYTES, MISC_OFF = LDSCTL_OFF + 320, LDS_BYTES = 147456;
constexpr int N1 = 5120;
constexpr size_t WS_CTL = 0, CTL_ZERO_BYTES = 256 * 1024;
constexpr int CW_BAR = 1024;
constexpr size_t WS_WIN = 1 * MiB  , WS_WOA = 11 * MiB, WS_WOB = 12 * MiB, WS_WOUT = 13 * MiB  ;
#define LDS_WAIT() asm volatile("s_waitcnt lgkmcnt(0)" ::: "memory")
constexpr size_t WS_HG = 16 * MiB, WS_YE = 16 * MiB, WS_ACT = 96 * MiB, WS_WGU = 176 * MiB, WS_WD = 208 * MiB, WS_H2M = 224 * MiB;
constexpr size_t WS_SELE = 15 * MiB, WS_SELW = WS_SELE + 128 * 1024, WS_SELP = WS_SELW + 128 * 1024, WS_ROW = WS_SELP + 128 * 1024;
constexpr int CW_CNT = 512;
constexpr int TAB_OFF = LDSCTL_OFF + 1024;

enum { PH_P0 = 0, PH_GEMM1, PH_PREP, PH_SCAN1, PH_SCAN2, PH_SCAN3, PH_MIX, PH_WOUT, PH_ROUTER, PH_GATHER, PH_MOE1, PH_MOE2, PH_FINAL, PH_END };
struct Args { const float* in[31]; float* out; unsigned char* ws; int ph_lo, ph_hi, li, pad; };

struct Frame { LAS unsigned char* lds; int wave, vcu, G; };
#define F_LANE ((int)(threadIdx.x & 63u))
#define F_TID ((int)threadIdx.x)

__device__ __forceinline__ unsigned pk2(float lo, float hi) { return (unsigned)f2bf(lo) | ((unsigned)f2bf(hi) << 16); }
__device__ __forceinline__ void p0_transpose_item(const float* __restrict__ W, int K, int N, bf16* WT, int ldt, int row_off, LAS float* scr, int kb, int nb, int lane) {
    const int k0 = 64 * kb, n0 = 32 * nb;
#pragma unroll 8
    for (int i = 0; i < 32; ++i) { const int kk = 2 * i + (lane >> 5); scr[kk * 33 + (lane & 31)] = W[(size_t)(k0 + kk) * N + n0 + (lane & 31)]; }
    LDS_WAIT(); asm volatile("" ::: "memory");
    const int c = lane & 7;
#pragma unroll
    for (int j = 0; j < 4; ++j) { const int n = (lane >> 3) + 8 * j; const LAS float* s = scr + (8 * c) * 33 + n;
        u32x4 o; o.x = pk2(s[0 * 33], s[1 * 33]); o.y = pk2(s[2 * 33], s[3 * 33]); o.z = pk2(s[4 * 33], s[5 * 33]); o.w = pk2(s[6 * 33], s[7 * 33]);
        *(u32x4*)(WT + (size_t)(row_off + n0 + n) * ldt + k0 + 8 * c) = o; }
    LDS_WAIT(); asm volatile("" ::: "memory");
}

struct Epi1 {
    static constexpr bool PERM = true;
    bf16* PA; bf16* ZB; bf16* GT; const float* b_gate;
    __device__ __forceinline__ bool operator()(f32x4 (&acc)[2][2][4][2], const pg8::Unit& u, int wr, int wc, int fr, int fq) const {
        const int row0 = u.pm * 256 + wr * 64 + fr;
        int mode, ldc, colt; bf16* base;
        if (u.pn < 8) { mode = 0; base = PA; ldc = PA_LD; colt = u.pn * 256; }
        else if (u.pn < 12) { mode = 1; base = ZB; ldc = 1024; colt = (u.pn - 8) * 256; }
        else { mode = 2; base = GT; ldc = 2048; colt = (u.pn - 12) * 256; }
        const int col0 = colt + wc * 32 + 8 * fq;
        f32x4 bv[2][2];
#pragma unroll
        for (int bj = 0; bj < 2; ++bj)
#pragma unroll
            for (int n = 0; n < 2; ++n) bv[bj][n] = (mode == 2) ? *(const f32x4*)(b_gate + col0 + bj * 128 + 4 * n) : (f32x4){0.f, 0.f, 0.f, 0.f};
#pragma unroll
        for (int ai = 0; ai < 2; ++ai)
#pragma unroll
            for (int m = 0; m < 4; ++m) { bf16* rowp = base + (size_t)(row0 + ai * 128 + m * 16) * ldc + col0;
#pragma unroll
                for (int bj = 0; bj < 2; ++bj) { f32x4 v0 = acc[ai][bj][m][0] + bv[bj][0], v1 = acc[ai][bj][m][1] + bv[bj][1];
                    if (mode == 1) { f32x2 a = pg8::gelu_pk((f32x2){v0[0], v0[1]}), b = pg8::gelu_pk((f32x2){v0[2], v0[3]}), c = pg8::gelu_pk((f32x2){v1[0], v1[1]}), d = pg8::gelu_pk((f32x2){v1[2], v1[3]});
                        v0 = (f32x4){a.x, a.y, b.x, b.y}; v1 = (f32x4){c.x, c.y, d.x, d.y}; }
                    if (mode == 2) {
#pragma unroll
                        for (int j = 0; j < 4; ++j) { v0[j] = pg8::fast_sigmoid(v0[j]); v1[j] = pg8::fast_sigmoid(v1[j]); } }
                    u32x4 w; w.x = pg8::cvt_pk_bf16(v0[0], v0[1]); w.y = pg8::cvt_pk_bf16(v0[2], v0[3]); w.z = pg8::cvt_pk_bf16(v1[0], v1[1]); w.w = pg8::cvt_pk_bf16(v1[2], v1[3]);
                    *(u32x4*)(rowp + bj * 128) = w; } }
        return false;
    }
};

struct MixOrder {
    const char *YA, *YB, *WA, *WB; int G, c;
    __device__ __forceinline__ bool next(int i, pg8::Unit& u) const {
        const int L = (i >> 1) * G + c; if (L >= 256) return false;
        pg8::tile_order(L, 64, 4, u.pm, u.pn); u.aux = i & 1;
        u.A = ((i & 1) ? YB : YA) + (size_t)u.pm * 256 * 512 * 2; u.B = ((i & 1) ? WB : WA) + (size_t)u.pn * 256 * 512 * 2; return true;
    }
};
__device__ __forceinline__ void unpack8(const u32x4 w, float (&f)[8]) {
    f[0] = __uint_as_float(w.x << 16); f[1] = __uint_as_float(w.x & 0xffff0000u); f[2] = __uint_as_float(w.y << 16); f[3] = __uint_as_float(w.y & 0xffff0000u);
    f[4] = __uint_as_float(w.z << 16); f[5] = __uint_as_float(w.z & 0xffff0000u); f[6] = __uint_as_float(w.w << 16); f[7] = __uint_as_float(w.w & 0xffff0000u);
}
struct EpiMix {
    static constexpr bool PERM = true;
    const bf16* GT; bf16* MIX;
    __device__ __forceinline__ bool operator()(f32x4 (&acc)[2][2][4][2], const pg8::Unit& u, int wr, int wc, int fr, int fq) const {
        const int row0 = u.pm * 256 + wr * 64 + fr, col0 = u.pn * 256 + wc * 32 + 8 * fq;
#pragma unroll
        for (int ai = 0; ai < 2; ++ai)
#pragma unroll
            for (int m = 0; m < 4; ++m) { const size_t row = (size_t)(row0 + ai * 128 + m * 16);
#pragma unroll
                for (int bj = 0; bj < 2; ++bj) { const int c = col0 + bj * 128;
                    float gb[8]; unpack8(*(const u32x4*)(GT + row * 2048 + 1024 + c), gb);
                    if (u.aux == 0) { float ga[8]; unpack8(*(const u32x4*)(GT + row * 2048 + c), ga);
#pragma unroll
                        for (int j = 0; j < 4; ++j) { acc[ai][bj][m][0][j] *= ga[j] * __builtin_amdgcn_rcpf(gb[j]); acc[ai][bj][m][1][j] *= ga[4 + j] * __builtin_amdgcn_rcpf(gb[4 + j]); }
                    } else { const f32x4 v0 = acc[ai][bj][m][0], v1 = acc[ai][bj][m][1];
                        u32x4 w; w.x = pg8::cvt_pk_bf16(v0[0] * gb[0], v0[1] * gb[1]); w.y = pg8::cvt_pk_bf16(v0[2] * gb[2], v0[3] * gb[3]);
                        w.z = pg8::cvt_pk_bf16(v1[0] * gb[4], v1[1] * gb[5]); w.w = pg8::cvt_pk_bf16(v1[2] * gb[6], v1[3] * gb[7]);
                        *(u32x4*)(MIX + row * 1024 + c) = w; } } }
        return u.aux == 0;
    }
};
struct EpiX1 {
    static constexpr bool PERM = false;
    const float* x; float* X1;
    __device__ __forceinline__ bool operator()(f32x4 (&acc)[2][2][4][2], const pg8::Unit& u, int wr, int wc, int fr, int fq) const {
        const int row0 = u.pm * 256 + wr * 64 + fr, col0 = u.pn * 256 + wc * 32 + 4 * fq;
#pragma unroll
        for (int ai = 0; ai < 2; ++ai)
#pragma unroll
            for (int m = 0; m < 4; ++m) { const size_t off = (size_t)(row0 + ai * 128 + m * 16) * 1024 + col0;
#pragma unroll
                for (int bj = 0; bj < 2; ++bj)
#pragma unroll
                    for (int n = 0; n < 2; ++n) *(f32x4*)(X1 + off + bj * 128 + n * 16) = *(const f32x4*)(x + off + bj * 128 + n * 16) + acc[ai][bj][m][n]; }
        return false;
    }
};

__device__ __forceinline__ void moe_tables(Frame& F, const unsigned* cnt) {
    volatile LAS int* tab = (volatile LAS int*)(F.lds + TAB_OFF);
    if (F_TID == 0) { int acc = 0; for (int e = 0; e < 32; ++e) { tab[e] = acc; acc += (int)((__hip_atomic_load(cnt + e, __ATOMIC_RELAXED, __HIP_MEMORY_SCOPE_AGENT) + 255u) >> 8); } tab[32] = acc; }
    __syncthreads();
}
struct MoeOrder {
    const char* A; const char* B; LAS const int* tab; int NT, nN, G, c; size_t a_tile, b_exp, b_tile;
    __device__ __forceinline__ bool next(int i, pg8::Unit& u) const {
        const int L = i * G + c; if (L >= NT * nN) return false;
        pg8::tile_order(L, NT, nN, u.pm, u.pn);
        int e = 0;
#pragma unroll 1
        for (int k = 1; k < 32; ++k) e += (u.pm >= tab[k]) ? 1 : 0;
        u.aux = e; u.A = A + (size_t)u.pm * a_tile; u.B = B + (size_t)e * b_exp + (size_t)u.pn * b_tile; return true;
    }
};
struct EpiAct {
    static constexpr bool PERM = true;
    bf16* ACT;
    __device__ __forceinline__ bool operator()(f32x4 (&acc)[2][2][4][2], const pg8::Unit& u, int wr, int wc, int fr, int fq) const {
        const int row0 = u.pm * 256 + wr * 64 + fr, col0 = u.pn * 128 + wc * 32 + 8 * fq;
#pragma unroll
        for (int ai = 0; ai < 2; ++ai)
#pragma unroll
            for (int m = 0; m < 4; ++m) { float o[8];
#pragma unroll
                for (int n = 0; n < 2; ++n)
#pragma unroll
                    for (int j = 0; j < 4; ++j) { const float g = acc[ai][0][m][n][j], up = acc[ai][1][m][n][j]; o[4 * n + j] = g * pg8::fast_sigmoid(g) * up; }
                u32x4 w; w.x = pg8::cvt_pk_bf16(o[0], o[1]); w.y = pg8::cvt_pk_bf16(o[2], o[3]); w.z = pg8::cvt_pk_bf16(o[4], o[5]); w.w = pg8::cvt_pk_bf16(o[6], o[7]);
                *(u32x4*)(ACT + (size_t)(row0 + ai * 128 + m * 16) * 256 + col0) = w; }
        return false;
    }
};
struct EpiYE {
    static constexpr bool PERM = true;
    bf16* YE;
    __device__ __forceinline__ bool operator()(f32x4 (&acc)[2][2][4][2], const pg8::Unit& u, int wr, int wc, int fr, int fq) const {
        const int row0 = u.pm * 256 + wr * 64 + fr, col0 = u.pn * 256 + wc * 32 + 8 * fq;
#pragma unroll
        for (int ai = 0; ai < 2; ++ai)
#pragma unroll
            for (int m = 0; m < 4; ++m) { bf16* rowp = YE + (size_t)(row0 + ai * 128 + m * 16) * 1024 + col0;
#pragma unroll
                for (int bj = 0; bj < 2; ++bj) { const f32x4 v0 = acc[ai][bj][m][0], v1 = acc[ai][bj][m][1];
                    u32x4 w; w.x = pg8::cvt_pk_bf16(v0[0], v0[1]); w.y = pg8::cvt_pk_bf16(v0[2], v0[3]); w.z = pg8::cvt_pk_bf16(v1[0], v1[1]); w.w = pg8::cvt_pk_bf16(v1[2], v1[3]);
                    *(u32x4*)(rowp + bj * 128) = w; } }
        return false;
    }
};

constexpr size_t WS_PHIT = 16 * MiB, WS_QT = 32 * MiB, WS_LT = 48 * MiB, WS_YL = 80 * MiB;
#define DPPQ(K) "quad_perm:[" #K "," #K "," #K "," #K "] row_mask:0xf bank_mask:0xf"
#define WKV_GROUP(P0, P1, P2, P3, L0, L1, L2, L3, VD, VB, VK, VR, VA) \
    asm volatile( \
        "v_mul_f32_dpp %0, %12, %0 " DPPQ(0) "\n\tv_mul_f32_dpp %4, %12, %4 " DPPQ(0) "\n\tv_mul_f32_dpp %1, %12, %1 " DPPQ(1) "\n\tv_mul_f32_dpp %5, %12, %5 " DPPQ(1) "\n\t" \
        "v_mul_f32_dpp %2, %12, %2 " DPPQ(2) "\n\tv_mul_f32_dpp %6, %12, %6 " DPPQ(2) "\n\tv_mul_f32_dpp %3, %12, %3 " DPPQ(3) "\n\tv_mul_f32_dpp %7, %12, %7 " DPPQ(3) "\n\t" \
        "v_fmac_f32_dpp %0, %13, %17 " DPPQ(0) "\n\tv_fmac_f32_dpp %4, %13, %18 " DPPQ(0) "\n\tv_fmac_f32_dpp %1, %13, %17 " DPPQ(1) "\n\tv_fmac_f32_dpp %5, %13, %18 " DPPQ(1) "\n\t" \
        "v_fmac_f32_dpp %2, %13, %17 " DPPQ(2) "\n\tv_fmac_f32_dpp %6, %13, %18 " DPPQ(2) "\n\tv_fmac_f32_dpp %3, %13, %17 " DPPQ(3) "\n\tv_fmac_f32_dpp %7, %13, %18 " DPPQ(3) "\n\t" \
        "v_fmac_f32_dpp %4, %14, %19 " DPPQ(0) "\n\tv_fmac_f32_dpp %5, %14, %19 " DPPQ(1) "\n\tv_fmac_f32_dpp %6, %14, %19 " DPPQ(2) "\n\tv_fmac_f32_dpp %7, %14, %19 " DPPQ(3) "\n\t" \
        "v_fmac_f32_dpp %8, %15, %0 " DPPQ(0) "\n\tv_fmac_f32_dpp %10, %16, %0 " DPPQ(0) "\n\tv_fmac_f32_dpp %9, %15, %4 " DPPQ(0) "\n\tv_fmac_f32_dpp %11, %16, %4 " DPPQ(0) "\n\t" \
        "v_fmac_f32_dpp %8, %15, %1 " DPPQ(1) "\n\tv_fmac_f32_dpp %10, %16, %1 " DPPQ(1) "\n\tv_fmac_f32_dpp %9, %15, %5 " DPPQ(1) "\n\tv_fmac_f32_dpp %11, %16, %5 " DPPQ(1) "\n\t" \
        "v_fmac_f32_dpp %8, %15, %2 " DPPQ(2) "\n\tv_fmac_f32_dpp %10, %16, %2 " DPPQ(2) "\n\tv_fmac_f32_dpp %9, %15, %6 " DPPQ(2) "\n\tv_fmac_f32_dpp %11, %16, %6 " DPPQ(2) "\n\t" \
        "v_fmac_f32_dpp %8, %15, %3 " DPPQ(3) "\n\tv_fmac_f32_dpp %10, %16, %3 " DPPQ(3) "\n\tv_fmac_f32_dpp %9, %15, %7 " DPPQ(3) "\n\tv_fmac_f32_dpp %11, %16, %7 " DPPQ(3) \
        : "+v"(P0), "+v"(P1), "+v"(P2), "+v"(P3), "+v"(L0), "+v"(L1), "+v"(L2), "+v"(L3), "+v"(q), "+v"(yl), "+v"(sa2p), "+v"(sa2l) \
        : "v"(VD), "v"(VB), "v"(VK), "v"(VR), "v"(VA), "v"(sa_p), "v"(sa_l), "v"(vv))

struct ScanBufs { const bf16 *R, *KK, *BV, *KM, *LW, *VV, *GG; bf16 *PHIT, *QT; float *LT, *YL; bf16 *XF; bf16* YA; };

__device__ __forceinline__ void scan_pass1(Frame& F, const ScanBufs& B) {
    LAS float* wl = (LAS float*)(F.lds + F.wave * 12288);
    const int lane = F_LANE, h = F.wave;
    for (int bc = F.vcu; bc < 256; bc += F.G) {
        const int b = bc >> 5, c = bc & 31; const size_t m0 = (size_t)b * T + c * 64; const int uid = (b * 8 + h) * 32 + c;
        float phi[64], l[64]; float one = 1.f; asm volatile("" : "+v"(one));
#pragma unroll
        for (int j = 0; j < 64; ++j) { phi[j] = (j == lane) ? one : 0.f; l[j] = 0.f; }
        float sa_p = -bf2f(B.KK[m0 * AW + h * 64 + lane]), sa_l = 0.f;
        const int ts = lane >> 3, c0 = 8 * (lane & 7);
        const size_t goff = (m0 + ts) * AW + h * 64 + c0;
        u32x4 pr[6];
        pr[0] = *(const u32x4*)(B.LW + goff); pr[1] = *(const u32x4*)(B.BV + goff); pr[2] = *(const u32x4*)(B.KM + goff); pr[3] = *(const u32x4*)(B.R + goff);
        pr[4] = *(const u32x4*)(B.KK + goff + AW); pr[5] = *(const u32x4*)(B.VV + goff);
        for (int sb = 0; sb < 8; ++sb) {
            asm volatile("" ::: "memory");
#pragma unroll
            for (int v = 0; v < 5; ++v) { float f[8]; unpack8(pr[v], f);
                if (v == 0) {
#pragma unroll
                    for (int i = 0; i < 8; ++i) f[i] = __expf(f[i]); }
                if (v == 4) {
#pragma unroll
                    for (int i = 0; i < 8; ++i) f[i] = -f[i]; }
                LAS float* dst = wl + (v * 8 + ts) * 64 + 2 * (lane & 7);
#pragma unroll
                for (int i = 0; i < 4; ++i) *(LAS f32x2*)(dst + 16 * i) = (f32x2){f[i], f[i + 4]}; }
            { float f[8]; unpack8(pr[5], f); LAS float* dst = wl + 2560 + ts * 64 + c0; *(LAS f32x4*)dst = (f32x4){f[0], f[1], f[2], f[3]}; *(LAS f32x4*)(dst + 4) = (f32x4){f[4], f[5], f[6], f[7]}; }
            asm volatile("" ::: "memory");
            if (sb < 7) { const size_t g2 = goff + (size_t)(sb + 1) * 8 * AW;
                pr[0] = *(const u32x4*)(B.LW + g2); pr[1] = *(const u32x4*)(B.BV + g2); pr[2] = *(const u32x4*)(B.KM + g2); pr[3] = *(const u32x4*)(B.R + g2);
                pr[4] = *(const u32x4*)(B.KK + g2 + AW); pr[5] = *(const u32x4*)(B.VV + g2); }
#pragma unroll 1
            for (int tt = 0; tt < 8; ++tt) {
                const LAS float* vb = wl + tt * 64 + 16 * (lane & 3);
                const float vv = wl[2560 + tt * 64 + lane];
                float q = 0.f, yl = 0.f, sa2p = 0.f, sa2l = 0.f;
                f32x4 vd = *(const LAS f32x4*)(vb), vbb = *(const LAS f32x4*)(vb + 512), vk = *(const LAS f32x4*)(vb + 1024), vr = *(const LAS f32x4*)(vb + 1536), va = *(const LAS f32x4*)(vb + 2048);
#pragma unroll
                for (int gc = 0; gc < 4; ++gc) {
                    f32x4 nd, nb, nk, nr, na;
                    if (gc < 3) { nd = *(const LAS f32x4*)(vb + 4 * gc + 4); nb = *(const LAS f32x4*)(vb + 512 + 4 * gc + 4); nk = *(const LAS f32x4*)(vb + 1024 + 4 * gc + 4);
                                  nr = *(const LAS f32x4*)(vb + 1536 + 4 * gc + 4); na = *(const LAS f32x4*)(vb + 2048 + 4 * gc + 4); }
                    __builtin_amdgcn_sched_barrier(0);
#pragma unroll
                    for (int gi = 0; gi < 4; ++gi) { const int g = 4 * gc + gi;
                        WKV_GROUP(phi[4 * g], phi[4 * g + 1], phi[4 * g + 2], phi[4 * g + 3], l[4 * g], l[4 * g + 1], l[4 * g + 2], l[4 * g + 3], vd[gi], vbb[gi], vk[gi], vr[gi], va[gi]); }
                    __builtin_amdgcn_sched_barrier(0);
                    if (gc < 3) { vd = nd; vbb = nb; vk = nk; vr = nr; va = na; }
                }
                const int t = sb * 8 + tt;
                B.QT[(size_t)uid * 4096 + t * 64 + lane] = f2bf(q);
                B.YL[(size_t)uid * 4096 + t * 64 + lane] = yl;
                sa_p = sa2p; sa_l = sa2l;
            }
        }
#pragma unroll
        for (int j = 0; j < 64; ++j) { B.PHIT[(size_t)uid * 4096 + j * 64 + lane] = f2bf(phi[j]); B.LT[(size_t)uid * 4096 + j * 64 + lane] = l[j]; }
    }
}

typedef float f32x16 __attribute__((ext_vector_type(16)));
__device__ __forceinline__ bf16x8 acc_frag(const f32x16& x, int s) {
    u32x4 w; w.x = pg8::cvt_pk_bf16(x[8 * s], x[8 * s + 1]); w.y = pg8::cvt_pk_bf16(x[8 * s + 2], x[8 * s + 3]); w.z = pg8::cvt_pk_bf16(x[8 * s + 4], x[8 * s + 5]); w.w = pg8::cvt_pk_bf16(x[8 * s + 6], x[8 * s + 7]);
    return __builtin_bit_cast(bf16x8, w);
}
__device__ __forceinline__ bf16x8 row_frag(const bf16* row, int s, int hh) {
    const u32x2 a = *(const u32x2*)(row + 16 * s + 4 * hh), b = *(const u32x2*)(row + 16 * s + 8 + 4 * hh);
    u32x4 w; w.x = a.x; w.y = a.y; w.z = b.x; w.w = b.y; return __builtin_bit_cast(bf16x8, w);
}
__device__ __forceinline__ void scan_pass2(Frame& F, const ScanBufs& B) {
    if (F.wave >= 2) return;
    const int it = F.wave, lane = F_LANE, l31 = lane & 31, hh = lane >> 5;
    for (int bh = F.vcu; bh < 64; bh += F.G) {
        f32x16 X[2];
#pragma unroll
        for (int jt = 0; jt < 2; ++jt)
#pragma unroll
            for (int r = 0; r < 16; ++r) X[jt][r] = 0.f;
        for (int c = 0; c < 32; ++c) { const size_t ub = ((size_t)bh * 32 + c) * 4096;
            bf16x8 xf[2][2];
#pragma unroll
            for (int jt = 0; jt < 2; ++jt)
#pragma unroll
                for (int s = 0; s < 2; ++s) { xf[jt][s] = acc_frag(X[jt], s);
                    *(bf16x8*)(B.XF + ub + (size_t)(((it * 2 + jt) * 2 + s) * 64 + lane) * 8) = xf[jt][s]; }
            f32x16 Xn[2];
#pragma unroll
            for (int j2 = 0; j2 < 2; ++j2)
#pragma unroll
                for (int r = 0; r < 16; ++r) Xn[j2][r] = B.LT[ub + (size_t)(32 * j2 + (r & 3) + 8 * (r >> 2) + 4 * hh) * 64 + 32 * it + l31];
#pragma unroll
            for (int j2 = 0; j2 < 2; ++j2) { const bf16* prow = B.PHIT + ub + (size_t)(32 * j2 + l31) * 64;
#pragma unroll
                for (int jt = 0; jt < 2; ++jt)
#pragma unroll
                    for (int s = 0; s < 2; ++s) Xn[j2] = __builtin_amdgcn_mfma_f32_32x32x16_bf16(row_frag(prow + 32 * jt, s, hh), xf[jt][s], Xn[j2], 0, 0, 0); }
            X[0] = Xn[0]; X[1] = Xn[1];
        }
    }
}
__device__ __forceinline__ void scan_pass3(Frame& F, const ScanBufs& B, const float* __restrict__ r_k, const float* __restrict__ lnx_g, const float* __restrict__ lnx_b) {
    const int lane = F_LANE, l31 = lane & 31, hh = lane >> 5, h = F.wave;
    for (int bc = F.vcu; bc < 256; bc += F.G) {
        const int b = bc >> 5, c = bc & 31; const size_t m0 = (size_t)b * T + c * 64; const size_t ub = ((size_t)(b * 8 + h) * 32 + c) * 4096;
        bf16x8 xa[2][2][2];
#pragma unroll
        for (int it = 0; it < 2; ++it)
#pragma unroll
            for (int jt = 0; jt < 2; ++jt)
#pragma unroll
                for (int s = 0; s < 2; ++s) xa[it][jt][s] = *(const bf16x8*)(B.XF + ub + (size_t)(((it * 2 + jt) * 2 + s) * 64 + lane) * 8);
#pragma unroll
        for (int tt = 0; tt < 2; ++tt) { const int t = 32 * tt + l31; const size_t m = m0 + t;
            f32x16 Y[2];
#pragma unroll
            for (int it = 0; it < 2; ++it)
#pragma unroll
                for (int g4 = 0; g4 < 4; ++g4) { const f32x4 y4 = *(const f32x4*)(B.YL + ub + (size_t)t * 64 + 32 * it + 8 * g4 + 4 * hh);
                    Y[it][4 * g4] = y4.x; Y[it][4 * g4 + 1] = y4.y; Y[it][4 * g4 + 2] = y4.z; Y[it][4 * g4 + 3] = y4.w; }
            const bf16* qrow = B.QT + ub + (size_t)t * 64;
#pragma unroll
            for (int jt = 0; jt < 2; ++jt)
#pragma unroll
                for (int s = 0; s < 2; ++s) { const bf16x8 qb = row_frag(qrow + 32 * jt, s, hh);
#pragma unroll
                    for (int it = 0; it < 2; ++it) Y[it] = __builtin_amdgcn_mfma_f32_32x32x16_bf16(xa[it][jt][s], qb, Y[it], 0, 0, 0); }
            float sum = 0.f;
#pragma unroll
            for (int it = 0; it < 2; ++it)
#pragma unroll
                for (int r = 0; r < 16; ++r) sum += Y[it][r];
            sum += __shfl_xor(sum, 32);
            const float mean = sum * (1.f / 64.f); float sq = 0.f;
#pragma unroll
            for (int it = 0; it < 2; ++it)
#pragma unroll
                for (int r = 0; r < 16; ++r) { const float d = Y[it][r] - mean; sq += d * d; }
            sq += __shfl_xor(sq, 32);
            const float rstd = rsqrtf(sq * (1.f / 64.f) + 64e-5f);
            float bsum = 0.f;
#pragma unroll
            for (int it = 0; it < 2; ++it)
#pragma unroll
                for (int g4 = 0; g4 < 4; ++g4) { const int ch = h * 64 + 32 * it + 8 * g4 + 4 * hh; const size_t o = m * AW + ch;
                    const u32x2 r2 = *(const u32x2*)(B.R + o), k2 = *(const u32x2*)(B.KM + o);
                    const f32x4 rk = *(const f32x4*)(r_k + ch);
                    const float r0 = __uint_as_float(r2.x << 16), r1 = __uint_as_float(r2.x & 0xffff0000u), r2f = __uint_as_float(r2.y << 16), r3 = __uint_as_float(r2.y & 0xffff0000u);
                    const float k0 = __uint_as_float(k2.x << 16), k1 = __uint_as_float(k2.x & 0xffff0000u), k2f = __uint_as_float(k2.y << 16), k3 = __uint_as_float(k2.y & 0xffff0000u);
                    bsum += (r0 * k0 * rk.x + r1 * k1 * rk.y) + (r2f * k2f * rk.z + r3 * k3 * rk.w); }
            bsum += __shfl_xor(bsum, 32);
            asm volatile("" : "+v"(bsum));
#pragma unroll
            for (int it = 0; it < 2; ++it)
#pragma unroll
                for (int g4 = 0; g4 < 4; ++g4) { const int ch = h * 64 + 32 * it + 8 * g4 + 4 * hh; const size_t o = m * AW + ch;
                    const u32x2 v2 = *(const u32x2*)(B.VV + o), g2 = *(const u32x2*)(B.GG + o);
                    const f32x4 lg = *(const f32x4*)(lnx_g + ch), lb = *(const f32x4*)(lnx_b + ch);
                    const float vv[4] = {__uint_as_float(v2.x << 16), __uint_as_float(v2.x & 0xffff0000u), __uint_as_float(v2.y << 16), __uint_as_float(v2.y & 0xffff0000u)};
                    const float gg[4] = {__uint_as_float(g2.x << 16), __uint_as_float(g2.x & 0xffff0000u), __uint_as_float(g2.y << 16), __uint_as_float(g2.y & 0xffff0000u)};
                    float o4[4];
#pragma unroll
                    for (int i = 0; i < 4; ++i) { const float yn = (Y[it][4 * g4 + i] - mean) * rstd * lg[i] + lb[i]; o4[i] = (yn + bsum * vv[i]) * gg[i]; }
                    u32x2 w; w.x = pg8::cvt_pk_bf16(o4[0], o4[1]); w.y = pg8::cvt_pk_bf16(o4[2], o4[3]);
                    *(u32x2*)(B.YA + m * AW + ch) = w; }
        }
    }
}

constexpr size_t WS_W2T = 15 * MiB + 512 * 1024, WS_A2T = WS_W2T + 64 * 1024, WS_G2T = WS_A2T + 64 * 1024, WS_WSB = WS_G2T + 160 * 1024;
constexpr int XS_LD = 296, VT_LD = 136;
__device__ __forceinline__ float bflo(unsigned w) { return __uint_as_float(w << 16); }
__device__ __forceinline__ float bfhi(unsigned w) { return __uint_as_float(w & 0xffff0000u); }
struct PrepBufs { const bf16* PA; const float *mu, *w0, *a0, *k_k, *k_a; const bf16 *W2T, *A2T, *G2T; bf16 *R, *KK, *BV, *KM, *LW, *VV, *GG; };
__device__ __forceinline__ f32x4 lerp4(const bf16* cur, const float* mu, bool first) {
    const u32x2 c = *(const u32x2*)cur; u32x2 p = *(const u32x2*)(cur - PA_LD); if (first) { p.x = 0u; p.y = 0u; }
    const f32x4 m4 = *(const f32x4*)mu; const f32x4 cv = (f32x4){bflo(c.x), bfhi(c.x), bflo(c.y), bfhi(c.y)}, pv = (f32x4){bflo(p.x), bfhi(p.x), bflo(p.y), bfhi(p.y)};
    return cv + m4 * (pv - cv);
}
__device__ __forceinline__ void prep_phase(Frame& F, const PrepBufs& P) {
    const int lane = F_LANE, l31 = lane & 31, hh = lane >> 5, h = F.wave;
    LAS bf16* xs = (LAS bf16*)F.lds;
    for (int tile = F.vcu; tile < M / 64; tile += F.G) { const size_t m0 = (size_t)tile * 64;
        __syncthreads();
        for (int it = lane; it < 288; it += 64) { const int tok = it / 36, c = it - tok * 36; const size_t m = m0 + 8 * h + tok; const bool first = (m & (T - 1)) == 0;
            const bf16* cp = P.PA + m * PA_LD + 1536 + 8 * c;
            const f32x4 x0 = lerp4(cp, P.mu + 1536 + 8 * c, first), x1 = lerp4(cp + 4, P.mu + 1536 + 8 * c + 4, first);
            float x[8] = {x0[0], x0[1], x0[2], x0[3], x1[0], x1[1], x1[2], x1[3]};
            if (c < 8) {
#pragma unroll
                for (int i = 0; i < 8; ++i) x[i] = 1.f - 2.f * __builtin_amdgcn_rcpf(1.f + __builtin_amdgcn_exp2f(2.8853900817779268f * x[i])); }
            else if (c >= 16) {
#pragma unroll
                for (int i = 0; i < 8; ++i) x[i] = pg8::fast_sigmoid(x[i]); }
            u32x4 w; w.x = pg8::cvt_pk_bf16(x[0], x[1]); w.y = pg8::cvt_pk_bf16(x[2], x[3]); w.z = pg8::cvt_pk_bf16(x[4], x[5]); w.w = pg8::cvt_pk_bf16(x[6], x[7]);
            *(LAS u32x4*)(xs + (8 * h + tok) * XS_LD + 8 * c) = w; }
        __syncthreads();
#pragma unroll 1
        for (int tt = 0; tt < 2; ++tt) {
            const LAS bf16* xrow = xs + (32 * tt + l31) * XS_LD + 8 * hh;
            const size_t m = m0 + 32 * tt + l31; const bool first = (m & (T - 1)) == 0;
            const bf16* prow = P.PA + m * PA_LD;
            float av[32], kl[32];
            {
                f32x16 acc[2];
#pragma unroll
                for (int i2 = 0; i2 < 2; ++i2)
#pragma unroll
                    for (int r = 0; r < 16; ++r) acc[i2][r] = 0.f;
#pragma unroll
                for (int ks = 0; ks < 4; ++ks) { const bf16x8 ba = *(const LAS bf16x8*)(xrow + 64 + 16 * ks);
#pragma unroll
                    for (int i2 = 0; i2 < 2; ++i2) acc[i2] = __builtin_amdgcn_mfma_f32_32x32x16_bf16(*(const bf16x8*)(P.A2T + (size_t)(h * 64 + 32 * i2 + l31) * 64 + 16 * ks + 8 * hh), ba, acc[i2], 0, 0, 0); }
#pragma unroll
                for (int i2 = 0; i2 < 2; ++i2)
#pragma unroll
                    for (int g4 = 0; g4 < 4; ++g4) { const f32x4 a04 = *(const f32x4*)(P.a0 + h * 64 + 32 * i2 + 8 * g4 + 4 * hh);
#pragma unroll
                        for (int i = 0; i < 4; ++i) av[(i2 * 4 + g4) * 4 + i] = pg8::fast_sigmoid(a04[i] + acc[i2][4 * g4 + i]); }
            }
            float ss = 0.f;
#pragma unroll
            for (int i2 = 0; i2 < 2; ++i2)
#pragma unroll
                for (int g4 = 0; g4 < 4; ++g4) { const int ch = h * 64 + 32 * i2 + 8 * g4 + 4 * hh; const f32x4 kv = lerp4(prow + 512 + ch, P.mu + 512 + ch, first); const f32x4 kk4 = *(const f32x4*)(P.k_k + ch);
#pragma unroll
                    for (int i = 0; i < 4; ++i) { kl[(i2 * 4 + g4) * 4 + i] = kv[i]; const float q = kv[i] * kk4[i]; ss += q * q; } }
            ss += __shfl_xor(ss, 32);
            const float inv = 1.f / fmaxf(sqrtf(ss), 1e-12f);
            asm volatile("" ::: "memory");
            {
                f32x16 acc[2];
#pragma unroll
                for (int i2 = 0; i2 < 2; ++i2)
#pragma unroll
                    for (int r = 0; r < 16; ++r) acc[i2][r] = 0.f;
#pragma unroll
                for (int ks = 0; ks < 4; ++ks) { const bf16x8 bw = *(const LAS bf16x8*)(xrow + 16 * ks);
#pragma unroll
                    for (int i2 = 0; i2 < 2; ++i2) acc[i2] = __builtin_amdgcn_mfma_f32_32x32x16_bf16(*(const bf16x8*)(P.W2T + (size_t)(h * 64 + 32 * i2 + l31) * 64 + 16 * ks + 8 * hh), bw, acc[i2], 0, 0, 0); }
#pragma unroll
                for (int i2 = 0; i2 < 2; ++i2)
#pragma unroll
                    for (int g4 = 0; g4 < 4; ++g4) { const int ch = h * 64 + 32 * i2 + 8 * g4 + 4 * hh; const f32x4 w04 = *(const f32x4*)(P.w0 + ch);
                        float lw[4];
#pragma unroll
                        for (int i = 0; i < 4; ++i) lw[i] = -0.60653066f * pg8::fast_sigmoid(w04[i] + acc[i2][4 * g4 + i]);
                        u32x2 w; w.x = pg8::cvt_pk_bf16(lw[0], lw[1]); w.y = pg8::cvt_pk_bf16(lw[2], lw[3]); *(u32x2*)(P.LW + m * AW + ch) = w; }
            }
            asm volatile("" ::: "memory");
            {
                f32x16 acc[2];
#pragma unroll
                for (int i2 = 0; i2 < 2; ++i2)
#pragma unroll
                    for (int r = 0; r < 16; ++r) acc[i2][r] = 0.f;
#pragma unroll
                for (int ks = 0; ks < 10; ++ks) { const bf16x8 bg = *(const LAS bf16x8*)(xrow + 128 + 16 * ks);
#pragma unroll
                    for (int i2 = 0; i2 < 2; ++i2) acc[i2] = __builtin_amdgcn_mfma_f32_32x32x16_bf16(*(const bf16x8*)(P.G2T + (size_t)(h * 64 + 32 * i2 + l31) * 160 + 16 * ks + 8 * hh), bg, acc[i2], 0, 0, 0); }
#pragma unroll
                for (int i2 = 0; i2 < 2; ++i2)
#pragma unroll
                    for (int g4 = 0; g4 < 4; ++g4) { const int ch = h * 64 + 32 * i2 + 8 * g4 + 4 * hh;
                        u32x2 w; w.x = pg8::cvt_pk_bf16(acc[i2][4 * g4], acc[i2][4 * g4 + 1]); w.y = pg8::cvt_pk_bf16(acc[i2][4 * g4 + 2], acc[i2][4 * g4 + 3]); *(u32x2*)(P.GG + m * AW + ch) = w; }
            }
            asm volatile("" ::: "memory");
#pragma unroll
            for (int i2 = 0; i2 < 2; ++i2)
#pragma unroll
                for (int g4 = 0; g4 < 4; ++g4) { const int ch = h * 64 + 32 * i2 + 8 * g4 + 4 * hh; const size_t o = m * AW + ch;
                    const f32x4 rv = lerp4(prow + ch, P.mu + ch, first), vv = lerp4(prow + 1024 + ch, P.mu + 1024 + ch, first);
                    const f32x4 kk4 = *(const f32x4*)(P.k_k + ch), ka4 = *(const f32x4*)(P.k_a + ch);
                    float kkv[4], bv[4], km[4];
#pragma unroll
                    for (int i = 0; i < 4; ++i) { const int q = (i2 * 4 + g4) * 4 + i; const float a = av[q], kx = kl[q]; kkv[i] = kx * kk4[i] * inv; bv[i] = kkv[i] * a; km[i] = kx * (1.f + (a - 1.f) * ka4[i]); }
                    u32x2 w;
                    w.x = pg8::cvt_pk_bf16(rv[0], rv[1]); w.y = pg8::cvt_pk_bf16(rv[2], rv[3]); *(u32x2*)(P.R + o) = w;
                    w.x = pg8::cvt_pk_bf16(kkv[0], kkv[1]); w.y = pg8::cvt_pk_bf16(kkv[2], kkv[3]); *(u32x2*)(P.KK + o) = w;
                    w.x = pg8::cvt_pk_bf16(bv[0], bv[1]); w.y = pg8::cvt_pk_bf16(bv[2], bv[3]); *(u32x2*)(P.BV + o) = w;
                    w.x = pg8::cvt_pk_bf16(km[0], km[1]); w.y = pg8::cvt_pk_bf16(km[2], km[3]); *(u32x2*)(P.KM + o) = w;
                    w.x = pg8::cvt_pk_bf16(vv[0], vv[1]); w.y = pg8::cvt_pk_bf16(vv[2], vv[3]); *(u32x2*)(P.VV + o) = w;
                    asm volatile("" ::: "memory"); }
        }
    }
}
__device__ __forceinline__ void gmlp_phase(Frame& F, const bf16* __restrict__ ZB, const float* __restrict__ lnv_g, const float* __restrict__ lnv_b, const bf16* __restrict__ WSB, const float* __restrict__ b_s, bf16* YB) {
    const int lane = F_LANE, l31 = lane & 31, hh = lane >> 5, tid = F_TID;
    LAS bf16* vt = (LAS bf16*)F.lds;
    LAS float* st = (LAS float*)(F.lds + 128 * VT_LD * 2);
    for (int unit = F.vcu; unit < 512; unit += F.G) { const int g = unit & 3; const size_t m0 = (size_t)(unit >> 2) * 128;
        __syncthreads();
        for (int i = 0; i < 16; ++i) { const int sidx = 16 * F.wave + i; float f[8]; unpack8(*(const u32x4*)(ZB + (m0 + sidx) * 1024 + 512 + 8 * lane), f);
            float sum = 0.f;
#pragma unroll
            for (int j = 0; j < 8; ++j) sum += f[j];
            const float mean = wave_sum(sum) * (1.f / 512.f); float q = 0.f;
#pragma unroll
            for (int j = 0; j < 8; ++j) { const float d = f[j] - mean; q += d * d; }
            const float var = wave_sum(q) * (1.f / 512.f);
            if (lane == 0) { st[2 * sidx] = mean; st[2 * sidx + 1] = rsqrtf(var + 1e-5f); } }
        __syncthreads();
        for (int it = tid; it < 2048; it += NTHREADS) { const int sidx = it >> 4, c = it & 15; const int ch = g * 128 + 8 * c;
            float f[8]; unpack8(*(const u32x4*)(ZB + (m0 + sidx) * 1024 + 512 + ch), f);
            const float mean = st[2 * sidx], rstd = st[2 * sidx + 1];
            const f32x4 g0 = *(const f32x4*)(lnv_g + ch), g1 = *(const f32x4*)(lnv_g + ch + 4), b0 = *(const f32x4*)(lnv_b + ch), b1 = *(const f32x4*)(lnv_b + ch + 4);
#pragma unroll
            for (int j = 0; j < 8; ++j) { const float gv = j < 4 ? g0[j & 3] : g1[j & 3], bv = j < 4 ? b0[j & 3] : b1[j & 3];
                vt[(8 * c + j) * VT_LD + sidx] = f2bf((f[j] - mean) * rstd * gv + bv); } }
        __syncthreads();
        const int tile_t = F.wave & 3;
#pragma unroll 1
        for (int dd = 0; dd < 2; ++dd) { const int tile_d = 2 * (F.wave >> 2) + dd;
            f32x16 acc;
#pragma unroll
            for (int r = 0; r < 16; ++r) acc[r] = 0.f;
            const LAS bf16* arow = vt + (32 * tile_d + l31) * VT_LD + 8 * hh; const bf16* brow = WSB + (size_t)(g * 128 + 32 * tile_t + l31) * 128 + 8 * hh;
            for (int ks = 0; ks < 2 * (tile_t + 1); ++ks) acc = __builtin_amdgcn_mfma_f32_32x32x16_bf16(*(const LAS bf16x8*)(arow + 16 * ks), *(const bf16x8*)(brow + 16 * ks), acc, 0, 0, 0);
            const int t = 32 * tile_t + l31; const size_t m = m0 + t; const float bs = b_s[g * 128 + t];
#pragma unroll
            for (int g4 = 0; g4 < 4; ++g4) { const int ch = g * 128 + 32 * tile_d + 8 * g4 + 4 * hh; const u32x2 u2 = *(const u32x2*)(ZB + m * 1024 + ch);
                u32x2 w; w.x = pg8::cvt_pk_bf16(bflo(u2.x) * (acc[4 * g4] + bs), bfhi(u2.x) * (acc[4 * g4 + 1] + bs)); w.y = pg8::cvt_pk_bf16(bflo(u2.y) * (acc[4 * g4 + 2] + bs), bfhi(u2.y) * (acc[4 * g4 + 3] + bs));
                *(u32x2*)(YB + m * AW + ch) = w; }
        }
    }
}

__global__ void __launch_bounds__(NTHREADS, 2) mega(Args args) {
    extern __shared__ __attribute__((aligned(16))) unsigned char lds_raw[];
    Frame F; F.lds = (LAS unsigned char*)lds_raw;
    F.wave = __builtin_amdgcn_readfirstlane((int)(threadIdx.x >> 6));
    F.G = gridDim.x; { const int bx = blockIdx.x; F.vcu = (F.G % 8 == 0) ? (bx % 8) * (F.G / 8) + bx / 8 : bx; }
    unsigned char* ws = args.ws;
    unsigned* ctl = (unsigned*)(ws + WS_CTL);
    for (int u = F_TID; u < (LDS_BYTES - LDSCTL_OFF) / 4; u += NTHREADS) ((LAS unsigned*)(F.lds + LDSCTL_OFF))[u] = 0u;
    __syncthreads();
    XcdBarrier bar = xcd_barrier_post(ctl + CW_BAR + args.li * XCD_BAR_WORDS, (volatile LAS unsigned*)(F.lds + MISC_OFF) + 8);
    const int lo = args.ph_lo, hi = args.ph_hi;
#define IN(k) (lo <= (k) && (k) < hi)
#define SEAM(k) do { if (IN(k) && IN((k) + 1)) xcd_barrier(bar); } while (0)
    bf16* WIN = (bf16*)(ws + WS_WIN); bf16* WOA = (bf16*)(ws + WS_WOA); bf16* WOB = (bf16*)(ws + WS_WOB); bf16* WOUT = (bf16*)(ws + WS_WOUT);
    bf16* H1 = (bf16*)args.out;
    bf16* PA = (bf16*)(ws + WS_PA), *ZB = (bf16*)(ws + WS_ZB), *GT = (bf16*)(ws + WS_GT);

    if (IN(PH_P0)) {
        LAS float* scr = (LAS float*)(F.lds + F.wave * 16384);
        const int gw = F.vcu * NWAVES + F.wave, NGW = F.G * NWAVES;
        constexpr int I_IN = 16 * 153, I_OA = 8 * 32, I_OUT = 16 * 32, NITEMS = I_IN + 2 * I_OA + I_OUT;
        for (int it = gw; it < NITEMS; it += NGW) {
            int r = it;
            if (r < I_IN) { const int kb = r / 153, nb = r % 153; p0_transpose_item(args.in[2], 1024, IN_COLS, WIN, 1024, (32 * nb >= A_COLS) ? 224 : 0, scr, kb, nb, F_LANE); continue; } r -= I_IN;
            if (r < I_OA) { p0_transpose_item(args.in[15], 512, 1024, WOA, 512, 0, scr, r / 32, r % 32, F_LANE); continue; } r -= I_OA;
            if (r < I_OA) { p0_transpose_item(args.in[20], 512, 1024, WOB, 512, 0, scr, r / 32, r % 32, F_LANE); continue; } r -= I_OA;
            p0_transpose_item(args.in[21], 1024, 1024, WOUT, 1024, 0, scr, r / 32, r % 32, F_LANE);
        }
        for (int i = gw * 64 + F_LANE; i < 224 * 1024 / 8; i += NGW * 64) ((u32x4*)(WIN + (size_t)A_COLS * 1024))[i] = (u32x4){0u, 0u, 0u, 0u};
        { bf16* W2T = (bf16*)(ws + WS_W2T); bf16* A2T = (bf16*)(ws + WS_A2T); bf16* G2T = (bf16*)(ws + WS_G2T); bf16* WSB = (bf16*)(ws + WS_WSB);
          const int gt = gw * 64 + F_LANE, NT_ = NGW * 64;
          for (int i = gt; i < 512 * 64; i += NT_) { const int n = i >> 6, k = i & 63; W2T[i] = f2bf(args.in[6][k * 512 + n]); A2T[i] = f2bf(args.in[8][k * 512 + n]); }
          for (int i = gt; i < 512 * 160; i += NT_) { const int n = i / 160, k = i - n * 160; G2T[i] = f2bf(args.in[9][k * 512 + n]); }
          for (int i = gt; i < 4 * 128 * 128; i += NT_) { const int tq = (i >> 7) & 127, sq = i & 127; WSB[i] = sq <= tq ? f2bf(args.in[18][i]) : (bf16)0; } }
        const float* x = args.in[0]; const float* g1 = args.in[1];
        for (int m = gw; m < M; m += NGW) {
            const f32x4* xr = (const f32x4*)(x + (size_t)m * D) + F_LANE;
            f32x4 v[4]; float s = 0.f;
#pragma unroll
            for (int j = 0; j < 4; ++j) { v[j] = xr[64 * j]; s += (v[j].x * v[j].x + v[j].y * v[j].y) + (v[j].z * v[j].z + v[j].w * v[j].w); }
            const float rs = rsqrtf(wave_sum(s) * (1.f / D) + 1e-6f);
            u32x2* o8 = (u32x2*)(H1 + (size_t)m * D) + F_LANE;
#pragma unroll
            for (int j = 0; j < 4; ++j) { const f32x4 gg = *((const f32x4*)g1 + F_LANE + 64 * j);
                u32x2 w; w.x = pk2(v[j].x * rs * gg.x, v[j].y * rs * gg.y); w.y = pk2(v[j].z * rs * gg.z, v[j].w * rs * gg.w); o8[64 * j] = w; }
        }
    }
    SEAM(PH_P0);
    if (IN(PH_GEMM1)) {
        pg8::Gemm g{D, D, D}; pg8::StaticOrder S; S.init(H1, WIN, D, D, M, N1, F.G, (int)blockIdx.x);
        Epi1 E{PA, ZB, GT, args.in[3]};
        pg8::gemm_phase<Epi1, pg8::StaticOrder, true, true>(F.lds, g, S, E);
    }
    SEAM(PH_GEMM1);
    if (IN(PH_PREP)) {
        PrepBufs PB{PA, args.in[4], args.in[5], args.in[7], args.in[10], args.in[11], (const bf16*)(ws + WS_W2T), (const bf16*)(ws + WS_A2T), (const bf16*)(ws + WS_G2T),
                    (bf16*)args.out, (bf16*)((char*)args.out + 16 * MiB), (bf16*)((char*)args.out + 32 * MiB), (bf16*)((char*)args.out + 48 * MiB), (bf16*)(ws + WS_LW), (bf16*)(ws + WS_VV), (bf16*)(ws + WS_GG)};
#ifndef NO_PREP
        prep_phase(F, PB);
#endif
#ifndef NO_GMLP
        gmlp_phase(F, ZB, args.in[16], args.in[17], (const bf16*)(ws + WS_WSB), args.in[19], (bf16*)(ws + WS_YB));
#endif
    }
    SEAM(PH_PREP);
    ScanBufs SB{(const bf16*)args.out, (const bf16*)((char*)args.out + 16 * MiB), (const bf16*)((char*)args.out + 32 * MiB), (const bf16*)((char*)args.out + 48 * MiB),
                (const bf16*)(ws + WS_LW), (const bf16*)(ws + WS_VV), (const bf16*)(ws + WS_GG), (bf16*)(ws + WS_PHIT), (bf16*)(ws + WS_QT), (float*)(ws + WS_LT), (float*)(ws + WS_YL),
                (bf16*)((char*)args.out + 16 * MiB), (bf16*)(ws + WS_YA)};
#ifndef NO_S1
    if (IN(PH_SCAN1)) scan_pass1(F, SB);
#endif
    SEAM(PH_SCAN1);
#ifndef NO_S2
    if (IN(PH_SCAN2)) scan_pass2(F, SB);
#endif
    SEAM(PH_SCAN2);
#ifndef NO_S3
    if (IN(PH_SCAN3)) scan_pass3(F, SB, args.in[12], args.in[13], args.in[14]);
#endif
    SEAM(PH_SCAN3);
    bf16* YB = (bf16*)(ws + WS_YB), *YA = (bf16*)(ws + WS_YA), *MIX = (bf16*)(ws + WS_MIX);
    float* X1 = args.out;
    if (IN(PH_MIX)) {
        pg8::Gemm g{AW, AW, AW}; MixOrder S{(const char*)YA, (const char*)YB, (const char*)WOA, (const char*)WOB, F.G, (int)blockIdx.x};
        EpiMix E{GT, MIX};
        pg8::gemm_phase<EpiMix, MixOrder, true, true>(F.lds, g, S, E);
    }
    SEAM(PH_MIX);
    if (IN(PH_WOUT)) {
        pg8::Gemm g{D, D, D}; pg8::StaticOrder S; S.init(MIX, WOUT, D, D, M, D, F.G, (int)blockIdx.x);
        EpiX1 E{args.in[0], X1};
        pg8::gemm_phase<EpiX1, pg8::StaticOrder, true, true>(F.lds, g, S, E);
    }
    SEAM(PH_WOUT);
    unsigned* cnt = ctl + CW_CNT;
    bf16* H2 = (bf16*)(ws + WS_H2M); bf16* HG = (bf16*)(ws + WS_HG); bf16* YE = (bf16*)(ws + WS_YE); bf16* ACT = (bf16*)(ws + WS_ACT); bf16* WGU = (bf16*)(ws + WS_WGU); bf16* WD = (bf16*)(ws + WS_WD);
    int2* SEL_E = (int2*)(ws + WS_SELE); float2* SEL_W = (float2*)(ws + WS_SELW); int2* SEL_P = (int2*)(ws + WS_SELP); int2* ROW = (int2*)(ws + WS_ROW);
    if (IN(PH_ROUTER)) {
        volatile LAS int* lcnt = (volatile LAS int*)(F.lds);
        const float* g2n = args.in[22]; const float* w_rg = args.in[23]; const float* b_rg = args.in[24]; const float* w_re = args.in[25]; const float* b_re = args.in[26];
        for (int mb = F.vcu; mb < M / 64; mb += F.G) {
            __syncthreads();
            if (F_TID < 64) lcnt[F_TID] = 0;
            __syncthreads();
            for (int i = 0; i < 8; ++i) { const int tl = F.wave * 8 + i, m = mb * 64 + tl;
                const f32x4* xr = (const f32x4*)(X1 + (size_t)m * D) + F_LANE;
                float h[16]; float sq = 0.f;
#pragma unroll
                for (int j = 0; j < 4; ++j) { const f32x4 v = xr[64 * j]; h[4 * j] = v.x; h[4 * j + 1] = v.y; h[4 * j + 2] = v.z; h[4 * j + 3] = v.w; sq += (v.x * v.x + v.y * v.y) + (v.z * v.z + v.w * v.w); }
                const float rs = rsqrtf(wave_sum(sq) * (1.f / D) + 1e-6f);
#pragma unroll
                for (int j = 0; j < 4; ++j) { const f32x4 gg = *((const f32x4*)g2n + F_LANE + 64 * j);
                    h[4 * j] *= rs * gg.x; h[4 * j + 1] *= rs * gg.y; h[4 * j + 2] *= rs * gg.z; h[4 * j + 3] *= rs * gg.w;
                    u32x2 w; w.x = pk2(h[4 * j], h[4 * j + 1]); w.y = pk2(h[4 * j + 2], h[4 * j + 3]); ((u32x2*)(H2 + (size_t)m * D))[F_LANE + 64 * j] = w; }
                float gl[4];
#pragma unroll
                for (int gi = 0; gi < 4; ++gi) gl[gi] = 0.f;
#pragma unroll
                for (int j = 0; j < 4; ++j)
#pragma unroll
                    for (int q = 0; q < 4; ++q) { const int c = 4 * F_LANE + 256 * j + q; const f32x4 wv = *(const f32x4*)(w_rg + c * 4); const float hv = h[4 * j + q];
                        gl[0] += hv * wv.x; gl[1] += hv * wv.y; gl[2] += hv * wv.z; gl[3] += hv * wv.w; }
#pragma unroll
                for (int gi = 0; gi < 4; ++gi) gl[gi] = wave_sum(gl[gi]) + b_rg[gi];
                int gs = 0; float gm = gl[0];
#pragma unroll
                for (int gi = 1; gi < 4; ++gi) if (gl[gi] > gm) { gm = gl[gi]; gs = gi; }
                float den = 0.f;
#pragma unroll
                for (int gi = 0; gi < 4; ++gi) den += expf(gl[gi] - gm);
                const float gp = 1.f / den;
                float el[8];
#pragma unroll
                for (int e = 0; e < 8; ++e) el[e] = 0.f;
#pragma unroll
                for (int j = 0; j < 4; ++j)
#pragma unroll
                    for (int q = 0; q < 4; ++q) { const int c = 4 * F_LANE + 256 * j + q; const float* wp = w_re + ((size_t)gs * D + c) * 8; const f32x4 w0 = *(const f32x4*)wp, w1 = *(const f32x4*)(wp + 4); const float hv = h[4 * j + q];
                        el[0] += hv * w0.x; el[1] += hv * w0.y; el[2] += hv * w0.z; el[3] += hv * w0.w; el[4] += hv * w1.x; el[5] += hv * w1.y; el[6] += hv * w1.z; el[7] += hv * w1.w; }
#pragma unroll
                for (int e = 0; e < 8; ++e) el[e] = wave_sum(el[e]) + b_re[gs * 8 + e];
                int i1 = 0; float m1 = el[0];
#pragma unroll
                for (int e = 1; e < 8; ++e) if (el[e] > m1) { m1 = el[e]; i1 = e; }
                int i2 = -1; float m2 = -INFINITY;
#pragma unroll
                for (int e = 0; e < 8; ++e) if (e != i1 && el[e] > m2) { m2 = el[e]; i2 = e; }
                const float w1 = 1.f / (1.f + expf(m2 - m1)), w2 = 1.f - w1;
                if (F_LANE == 0) { const int e1 = gs * 8 + i1, e2 = gs * 8 + i2;
                    SEL_E[m] = make_int2(e1, e2); SEL_W[m] = make_float2(w1 * gp, w2 * gp);
                    lcnt[64 + 2 * tl] = __hip_atomic_fetch_add((LAS int*)&lcnt[e1], 1, __ATOMIC_RELAXED, __HIP_MEMORY_SCOPE_WORKGROUP);
                    lcnt[64 + 2 * tl + 1] = __hip_atomic_fetch_add((LAS int*)&lcnt[e2], 1, __ATOMIC_RELAXED, __HIP_MEMORY_SCOPE_WORKGROUP);
                    lcnt[192 + 2 * tl] = e1; lcnt[192 + 2 * tl + 1] = e2; }
            }
            __syncthreads();
            if (F_TID < 32) lcnt[32 + F_TID] = (int)__hip_atomic_fetch_add(cnt + F_TID, (unsigned)lcnt[F_TID], __ATOMIC_RELAXED, __HIP_MEMORY_SCOPE_AGENT);
            __syncthreads();
            if (F_TID < 64) { const int m = mb * 64 + F_TID; const int e1 = lcnt[192 + 2 * F_TID], e2 = lcnt[192 + 2 * F_TID + 1];
                SEL_P[m] = make_int2(lcnt[32 + e1] + lcnt[64 + 2 * F_TID], lcnt[32 + e2] + lcnt[64 + 2 * F_TID + 1]); }
        }
        __syncthreads();
        LAS float* scr = (LAS float*)(F.lds + 4096 + F.wave * 12288);
        const int gw = F.vcu * NWAVES + F.wave, NGW = F.G * NWAVES;
        for (int it = gw; it < 3 * 4096; it += NGW) { const int which = it >> 12, r = it & 4095;
            if (which < 2) { const int e = r >> 7, kb = (r >> 3) & 15, nb = r & 7;
                p0_transpose_item(args.in[27 + which] + (size_t)e * 1024 * 256, 1024, 256, WGU + (size_t)e * 512 * 1024, 1024, ((32 * nb) >> 7) * 128 + which * 128, scr, kb, nb, F_LANE); }
            else { const int e = r >> 7, kb = (r >> 5) & 3, nb = r & 31;
                p0_transpose_item(args.in[29] + (size_t)e * 256 * 1024, 256, 1024, WD + (size_t)e * 1024 * 256, 256, 0, scr, kb, nb, F_LANE); } }
    }
    SEAM(PH_ROUTER);
    if (IN(PH_GATHER)) {
        moe_tables(F, cnt);
        LAS const int* tab = (LAS const int*)(F.lds + TAB_OFF);
        const int gw = F.vcu * NWAVES + F.wave, NGW = F.G * NWAVES;
        for (int m = gw; m < M; m += NGW) { const int2 se = SEL_E[m]; const int2 sp = SEL_P[m];
            const int r1 = tab[se.x] * 256 + sp.x, r2 = tab[se.y] * 256 + sp.y;
            const u32x4* src = (const u32x4*)(H2 + (size_t)m * D); const u32x4 a = src[F_LANE], b = src[F_LANE + 64];
            u32x4* d1 = (u32x4*)(HG + (size_t)r1 * D); u32x4* d2 = (u32x4*)(HG + (size_t)r2 * D);
            d1[F_LANE] = a; d1[F_LANE + 64] = b; d2[F_LANE] = a; d2[F_LANE + 64] = b;
            if (F_LANE == 0) ROW[m] = make_int2(r1, r2); }
    }
    SEAM(PH_GATHER);
    if (IN(PH_MOE1)) {
        moe_tables(F, cnt);
        LAS const int* tab = (LAS const int*)(F.lds + TAB_OFF);
        pg8::Gemm g{D, D, D}; MoeOrder S{(const char*)HG, (const char*)WGU, tab, tab[32], 2, F.G, (int)blockIdx.x, (size_t)256 * 1024 * 2, (size_t)512 * 1024 * 2, (size_t)256 * 1024 * 2};
        EpiAct E{ACT};
        pg8::gemm_phase<EpiAct, MoeOrder, true, true>(F.lds, g, S, E);
    }
    SEAM(PH_MOE1);
    if (IN(PH_MOE2)) {
        moe_tables(F, cnt);
        LAS const int* tab = (LAS const int*)(F.lds + TAB_OFF);
        pg8::Gemm g{256, 256, 256}; MoeOrder S{(const char*)ACT, (const char*)WD, tab, tab[32], 4, F.G, (int)blockIdx.x, (size_t)256 * 256 * 2, (size_t)1024 * 256 * 2, (size_t)256 * 256 * 2};
        EpiYE E{YE};
        pg8::gemm_phase<EpiYE, MoeOrder, true, true>(F.lds, g, S, E);
    }
    SEAM(PH_MOE2);
    if (IN(PH_FINAL)) {
        const int gw = F.vcu * NWAVES + F.wave, NGW = F.G * NWAVES; const float* fg = args.in[30];
        for (int m = gw; m < M; m += NGW) { const int2 rw = ROW[m]; const float2 sw = SEL_W[m];
            const f32x4* xr = (const f32x4*)(X1 + (size_t)m * D) + F_LANE; const u32x2* y1 = (const u32x2*)(YE + (size_t)rw.x * D) + F_LANE; const u32x2* y2 = (const u32x2*)(YE + (size_t)rw.y * D) + F_LANE;
            f32x4 v[4]; float sq = 0.f;
#pragma unroll
            for (int j = 0; j < 4; ++j) { const f32x4 xv = xr[64 * j]; const u32x2 a = y1[64 * j], b = y2[64 * j];
                v[j].x = xv.x + sw.x * __uint_as_float(a.x << 16) + sw.y * __uint_as_float(b.x << 16);
                v[j].y = xv.y + sw.x * __uint_as_float(a.x & 0xffff0000u) + sw.y * __uint_as_float(b.x & 0xffff0000u);
                v[j].z = xv.z + sw.x * __uint_as_float(a.y << 16) + sw.y * __uint_as_float(b.y << 16);
                v[j].w = xv.w + sw.x * __uint_as_float(a.y & 0xffff0000u) + sw.y * __uint_as_float(b.y & 0xffff0000u);
                sq += (v[j].x * v[j].x + v[j].y * v[j].y) + (v[j].z * v[j].z + v[j].w * v[j].w); }
            const float rs = rsqrtf(wave_sum(sq) * (1.f / D) + 1e-6f);
            f32x4* o = (f32x4*)(args.out + (size_t)m * D) + F_LANE;
#pragma unroll
            for (int j = 0; j < 4; ++j) { const f32x4 gg = *((const f32x4*)fg + F_LANE + 64 * j); o[64 * j] = (f32x4){v[j].x * rs * gg.x, v[j].y * rs * gg.y, v[j].z * rs * gg.z, v[j].w * rs * gg.w}; }
        }
    }
#undef IN
#undef SEAM
}
}

extern "C" void kernel_launch(void* const* d_in, const int* in_sizes, int n_in, void* d_out, int out_size, void* d_ws, size_t ws_size, hipStream_t stream) {
    auto F = [&](int i) { return (const float*)d_in[i]; };
    char* ws = (char*)d_ws; char* ob = (char*)d_out;
    bf16* H1 = (bf16*)ob;
    bf16* R = (bf16*)ob, *KK = (bf16*)(ob + 16 * MiB), *BV = (bf16*)(ob + 32 * MiB), *KM = (bf16*)(ob + 48 * MiB);
    bf16* PA = (bf16*)(ws + WS_PA), *ZB = (bf16*)(ws + WS_ZB), *GT = (bf16*)(ws + WS_GT), *LW = (bf16*)(ws + WS_LW), *VV = (bf16*)(ws + WS_VV), *GG = (bf16*)(ws + WS_GG);
    bf16* YB = (bf16*)(ws + WS_YB), *YA = (bf16*)(ws + WS_YA), *MIX = (bf16*)(ws + WS_MIX), *H2 = (bf16*)(ws + WS_H2);
    float* Y = (float*)(ws + WS_Y); float* X1 = (float*)(ws + WS_GT);
    int2* SEL_E = (int2*)(ws + WS_SEL); float2* SEL_W = (float2*)(ws + WS_SEL + 256 * 1024);
    static int grid = 0;
    if (grid == 0) {
        int dev = 0, cus = 0;
        if (hipGetDevice(&dev) != hipSuccess || hipDeviceGetAttribute(&cus, hipDeviceAttributeMultiprocessorCount, dev) != hipSuccess) { grid = -1; return; }
        if (hipFuncSetAttribute((const void*)mega, hipFuncAttributeMaxDynamicSharedMemorySize, LDS_BYTES) != hipSuccess) { grid = -1; return; }
        grid = cus;
    }
    if (grid < 0) return;
    (void)hipMemsetAsync(ws + WS_CTL, 0, CTL_ZERO_BYTES, stream);
    Args a{};
    for (int i = 0; i < 31; ++i) a.in[i] = (const float*)d_in[i];
    a.out = (float*)d_out; a.ws = (unsigned char*)d_ws;
    auto launch = [&](int lo, int hi, int li) { a.ph_lo = lo; a.ph_hi = hi; a.li = li; hipLaunchKernelGGL(mega, dim3(grid), dim3(NTHREADS), LDS_BYTES, stream, a); };
    launch(PH_P0, PH_END, 0);
}
```

```cpp
#ifndef REP_PH
#define REP_PH -1
#endif
#include <hip/hip_runtime.h>
#include <stdint.h>
#include <math.h>

namespace {
typedef unsigned short bf16;
constexpr int D = 1024, BATCH = 8, T = 2048, M = BATCH * T;
constexpr int AW = 512;
constexpr int A_COLS = 1824, B_COLS = 1024, IN_COLS = 4896;
constexpr int PA_LD = 2048;
constexpr size_t MiB = 1u << 20;
constexpr size_t WS_PA = 16 * MiB, WS_ZB = 80 * MiB, WS_GT = 112 * MiB, WS_LW = 176 * MiB, WS_VV = 192 * MiB, WS_GG = 208 * MiB,
                 WS_YB = 224 * MiB, WS_YA = 240 * MiB, WS_Y = 16 * MiB  , WS_MIX = 48 * MiB, WS_H2 = 80 * MiB, WS_SEL = 15 * MiB;

__device__ __forceinline__ float bf2f(bf16 b) { return __uint_as_float(((unsigned)b) << 16); }
__device__ __forceinline__ bf16 f2bf(float f) { unsigned u = __float_as_uint(f); u += 0x7fffu + ((u >> 16) & 1u); return (bf16)(u >> 16); }
__device__ __forceinline__ float wave_sum(float v) {
#pragma unroll
    for (int o = 1; o < 64; o <<= 1) v += __shfl_xor(v, o);
    return v;
}
__device__ __forceinline__ float sigmoidf_(float x) { return 1.f / (1.f + expf(-x)); }

#define LAS __attribute__((address_space(3)))
#define GAS __attribute__((address_space(1)))
typedef short bf16x8 __attribute__((ext_vector_type(8)));
typedef float f32x4 __attribute__((ext_vector_type(4)));
typedef float f32x2 __attribute__((ext_vector_type(2)));
typedef unsigned u32x4 __attribute__((ext_vector_type(4)));
typedef unsigned u32x2 __attribute__((ext_vector_type(2)));

namespace pg8 {
constexpr int BM = 256, BK = 64, HALF = 128, HTB = HALF * BK * 2, STAGE_BYTES = 8 * HTB, NXCD = 8, WGM = 8;
__device__ __forceinline__ int lds_byte(int r, int c) { const int st = (r >> 4) * 2 + (c >> 5), rr = r & 15, cc = c & 31, ob = rr * 64 + cc * 2; return st * 1024 + (ob ^ (((ob >> 9) & 1) << 5)); }
__device__ __forceinline__ void stage_rc(int b, int& R, int& C) { const int st = b / 1024, sb = b % 1024, swz = sb ^ (((sb >> 9) & 1) << 5); R = (st >> 1) * 16 + swz / 64; C = (st & 1) * 32 + (swz % 64) / 2; }
__device__ __forceinline__ int perm32(int rho) { const int n = rho >> 4, i = rho & 15; return 8 * (i >> 2) + 4 * n + (i & 3); }

struct Unit { int pm, pn; const char* A; const char* B; int aux; };
struct Gemm { int lda, ldb, K; };

__device__ __forceinline__ void tile_order(int L, int nM, int nN, int& pm, int& pn) {
    const int nwg = nM * nN; int wgid = L; { const int q = nwg / NXCD, r = nwg % NXCD, xcd = wgid % NXCD, off = wgid / NXCD; wgid = (xcd < r ? xcd * (q + 1) : r * (q + 1) + (xcd - r) * q) + off; }
    const int nig = WGM * nN, gid = wgid / nig, fm = gid * WGM, gsz = (nM - fm) < WGM ? (nM - fm) : WGM;
    pm = fm + ((wgid % nig) % gsz); pn = (wgid % nig) / gsz;
}
struct StaticOrder {
    const char* A; const char* B; int lda, ldb, nM, nN, nwg, G, c;
    __device__ void init(const void* A_, const void* B_, int lda_, int ldb_, int M, int N, int G_, int c_) { A = (const char*)A_; B = (const char*)B_; lda = lda_; ldb = ldb_; nM = M / BM; nN = N / BM; nwg = nM * nN; G = G_; c = c_; }
    __device__ __forceinline__ bool next(int i, Unit& u) const {
        const int L = i * G + c; if (L >= nwg) return false;
        tile_order(L, nM, nN, u.pm, u.pn);
        u.A = A + (size_t)u.pm * BM * lda * 2; u.B = B + (size_t)u.pn * BM * ldb * 2; u.aux = 0; return true;
    }
};

typedef __bf16 bf16x2_t __attribute__((ext_vector_type(2)));
__device__ __forceinline__ unsigned cvt_pk_bf16(float lo, float hi) { f32x2 v = {lo, hi}; bf16x2_t b = __builtin_convertvector(v, bf16x2_t); return __builtin_bit_cast(unsigned, b); }
__device__ __forceinline__ f32x2 gelu_pk(f32x2 v) {
    const f32x2 av = __builtin_elementwise_abs(v), d = av * 0.2316418882f + 1.0f;
    f32x2 t; t.x = __builtin_amdgcn_rcpf(d.x); t.y = __builtin_amdgcn_rcpf(d.y);
    f32x2 q = t * 0.5307027145f + (-0.7265760135f); q = q * t + 0.7107068705f; q = q * t + (-0.142248368f); q = q * t + 0.127414796f; q = q * t;
    const f32x2 s = (v * v) * (-0.72134752044f);
    f32x2 e; e.x = __builtin_amdgcn_exp2f(s.x); e.y = __builtin_amdgcn_exp2f(s.y);
    const f32x2 m = v * (q * e), r = v - m;
    f32x2 o; o.x = v.x < 0.f ? m.x : r.x; o.y = v.y < 0.f ? m.y : r.y; return o;
}
__device__ __forceinline__ float fast_sigmoid(float x) { return __builtin_amdgcn_rcpf(1.0f + __builtin_amdgcn_exp2f(-1.4426950408889634f * x)); }

template <class Epi, class Sched, bool ALIGN_EPI, bool SP2>
__device__ __forceinline__ void gemm_phase(LAS unsigned char* lds, const Gemm g, const Sched& S, const Epi& E) {
    int tid_ = threadIdx.x; asm volatile("" : "+v"(tid_));
    const int tid = tid_, wid = __builtin_amdgcn_readfirstlane(tid >> 6), lane = tid & 63, wr = wid >> 2, wc = wid & 3, fr = lane & 15, fq = lane >> 4;
    const int K = g.K, nt = K / BK;
    unsigned voffA[2], voffB[2];
#pragma unroll
    for (int i = 0; i < 2; ++i) { int R, C; stage_rc(tid * 16 + i * 8192, R, C); const int Rb = Epi::PERM ? ((R & ~31) + perm32(R & 31)) : R;
        voffA[i] = (unsigned)(R * g.lda + C) * 2u; voffB[i] = (unsigned)(Rb * g.ldb + C) * 2u; }
    const size_t kstep = (size_t)(BK * 2);
    const size_t hstepA = (size_t)HALF * g.lda * 2, hstepB = (size_t)HALF * g.ldb * 2;
    const unsigned ldsw = (unsigned)wid * 1024u;
    const int aoff = lds_byte(wr * 64 + fr, fq * 8), boff = lds_byte(wc * 32 + fr, fq * 8);
#define PG8_SA(b, h) (((b) * 2 + (h)) * HTB)
#define PG8_SB(b, h) ((4 + (b) * 2 + (h)) * HTB)
#define PG8_STAGE(bufoff, gbase, voff) do { _Pragma("unroll") for (int _i = 0; _i < 2; ++_i) \
        __builtin_amdgcn_global_load_lds((const unsigned*)((const char*)(gbase) + (voff)[_i]), (LAS unsigned*)(lds + (bufoff) + ldsw + _i * 8192), 16, 0, 0); } while (0)
#define PG8_LDA(dst, b, h) do { _Pragma("unroll") for (int m = 0; m < 4; ++m) _Pragma("unroll") for (int k = 0; k < 2; ++k) dst[m][k] = *(const LAS bf16x8*)(lds + PG8_SA(b, h) + aoff + m * 2048 + k * 1024); } while (0)
#define PG8_LDB(dst, b, h) do { _Pragma("unroll") for (int n = 0; n < 2; ++n) _Pragma("unroll") for (int k = 0; k < 2; ++k) dst[n][k] = *(const LAS bf16x8*)(lds + PG8_SB(b, h) + boff + n * 2048 + k * 1024); } while (0)
#define PG8_MMA(ai, bj, At, Bt) do { __builtin_amdgcn_s_setprio(1); _Pragma("unroll") for (int m = 0; m < 4; ++m) _Pragma("unroll") for (int n = 0; n < 2; ++n) _Pragma("unroll") for (int k = 0; k < 2; ++k) \
        acc[ai][bj][m][n] = __builtin_amdgcn_mfma_f32_16x16x32_bf16(Bt[n][k], At[m][k], acc[ai][bj][m][n], 0, 0, 0); __builtin_amdgcn_s_setprio(0); } while (0)
#define PG8_WAIT_V(n) asm volatile("s_waitcnt vmcnt(" #n ")" ::: "memory")
#define PG8_WAIT_L(n) asm volatile("s_waitcnt lgkmcnt(" #n ")" ::: "memory")
#define PG8_BAR __builtin_amdgcn_s_barrier()
#define PG8_SCHED __builtin_amdgcn_sched_barrier(0)
    Unit cur, nxt; int ui = 0;
    if (!S.next(0, cur)) return;
    f32x4 acc[2][2][4][2];
#pragma unroll
    for (int a = 0; a < 2; ++a)
#pragma unroll
        for (int b = 0; b < 2; ++b)
#pragma unroll
            for (int m = 0; m < 4; ++m)
#pragma unroll
                for (int n = 0; n < 2; ++n) acc[a][b][m][n] = (f32x4){0.f, 0.f, 0.f, 0.f};
    bf16x8 At[4][2], B0[2][2], B1[2][2];
    const char* cA = cur.A; const char* cB = cur.B;
    if constexpr (SP2) {
        PG8_STAGE(PG8_SB(0, 0), cB, voffB); PG8_STAGE(PG8_SB(0, 1), cB + hstepB, voffB); PG8_STAGE(PG8_SA(0, 0), cA, voffA); PG8_STAGE(PG8_SA(0, 1), cA + hstepA, voffA);
        if (wr == 1) PG8_BAR;
        PG8_WAIT_V(2); PG8_BAR;
        PG8_STAGE(PG8_SB(1, 0), cB + kstep, voffB); PG8_STAGE(PG8_SA(1, 0), cA + kstep, voffA); PG8_STAGE(PG8_SB(1, 1), cB + hstepB + kstep, voffB);
        PG8_WAIT_V(6); PG8_BAR;
    } else {
        PG8_STAGE(PG8_SB(0, 0), cB, voffB); PG8_STAGE(PG8_SA(0, 0), cA, voffA); PG8_STAGE(PG8_SB(0, 1), cB + hstepB, voffB); PG8_STAGE(PG8_SA(0, 1), cA + hstepA, voffA);
        if (wr == 1) PG8_BAR;
        PG8_WAIT_V(4); PG8_BAR;
        PG8_STAGE(PG8_SB(1, 0), cB + kstep, voffB); PG8_STAGE(PG8_SA(1, 0), cA + kstep, voffA); PG8_STAGE(PG8_SB(1, 1), cB + hstepB + kstep, voffB);
        PG8_WAIT_V(6); PG8_BAR;
    }
    for (;;) {
        const bool has_next = S.next(ui + 1, nxt);
        const char* nA = has_next ? nxt.A : cA; const char* nB = has_next ? nxt.B : cB;
#pragma unroll 1
        for (int t = 0; t < nt; t += 2) {
            const bool last = (t == nt - 2);
            const char* a1 = cA + (size_t)(t + 1) * kstep;
            const char* a2 = last ? nA : cA + (size_t)(t + 2) * kstep; const char* b2 = last ? nB : cB + (size_t)(t + 2) * kstep;
            const char* a3 = a2 + kstep; const char* b3 = b2 + kstep;
            if constexpr (SP2) {
            PG8_LDB(B0, 0, 0); PG8_LDB(B1, 0, 1); PG8_SCHED; PG8_LDA(At, 0, 0); PG8_STAGE(PG8_SA(1, 1), a1 + hstepA, voffA);
            PG8_WAIT_V(8); PG8_WAIT_L(0); PG8_BAR; PG8_MMA(0, 0, At, B0); PG8_MMA(0, 1, At, B1); PG8_BAR; PG8_SCHED;
            PG8_LDA(At, 0, 1); PG8_STAGE(PG8_SB(0, 0), b2, voffB); PG8_STAGE(PG8_SB(0, 1), b2 + hstepB, voffB); PG8_STAGE(PG8_SA(0, 0), a2, voffA);
            PG8_WAIT_V(8); PG8_WAIT_L(0); PG8_BAR; PG8_MMA(1, 0, At, B0); PG8_MMA(1, 1, At, B1); PG8_BAR; PG8_SCHED;
            PG8_LDB(B0, 1, 0); PG8_LDB(B1, 1, 1); PG8_SCHED; PG8_LDA(At, 1, 0); PG8_STAGE(PG8_SA(0, 1), a2 + hstepA, voffA);
            PG8_WAIT_V(8); PG8_WAIT_L(0); PG8_BAR; PG8_MMA(0, 0, At, B0); PG8_MMA(0, 1, At, B1); PG8_BAR; PG8_SCHED;
            PG8_LDA(At, 1, 1); PG8_STAGE(PG8_SB(1, 0), b3, voffB); PG8_STAGE(PG8_SB(1, 1), b3 + hstepB, voffB); PG8_STAGE(PG8_SA(1, 0), a3, voffA);
            PG8_WAIT_V(8); PG8_WAIT_L(0); PG8_BAR; PG8_MMA(1, 0, At, B0); PG8_MMA(1, 1, At, B1); PG8_BAR; PG8_SCHED;
            } else {
            PG8_LDB(B0, 0, 0); PG8_SCHED; PG8_LDA(At, 0, 0); PG8_STAGE(PG8_SA(1, 1), a1 + hstepA, voffA);
            PG8_WAIT_L(8); PG8_BAR; PG8_WAIT_L(0); PG8_MMA(0, 0, At, B0); PG8_BAR; PG8_SCHED;
            PG8_LDB(B1, 0, 1); PG8_STAGE(PG8_SB(0, 0), b2, voffB);
            PG8_BAR; PG8_WAIT_L(0); PG8_MMA(0, 1, At, B1); PG8_BAR;
            PG8_LDA(At, 0, 1); PG8_STAGE(PG8_SA(0, 0), a2, voffA);
            PG8_BAR; PG8_WAIT_L(0); PG8_MMA(1, 0, At, B0); PG8_BAR; PG8_SCHED;
            PG8_STAGE(PG8_SB(0, 1), b2 + hstepB, voffB);
            PG8_WAIT_V(6); PG8_BAR; PG8_MMA(1, 1, At, B1); PG8_BAR;
            PG8_LDB(B0, 1, 0); PG8_SCHED; PG8_LDA(At, 1, 0); PG8_STAGE(PG8_SA(0, 1), a2 + hstepA, voffA);
            PG8_WAIT_L(8); PG8_BAR; PG8_WAIT_L(0); PG8_MMA(0, 0, At, B0); PG8_BAR; PG8_SCHED;
            PG8_LDB(B1, 1, 1); PG8_STAGE(PG8_SB(1, 0), b3, voffB);
            PG8_BAR; PG8_WAIT_L(0); PG8_MMA(0, 1, At, B1); PG8_BAR;
            PG8_LDA(At, 1, 1); PG8_STAGE(PG8_SA(1, 0), a3, voffA);
            PG8_BAR; PG8_WAIT_L(0); PG8_MMA(1, 0, At, B0); PG8_BAR; PG8_SCHED;
            PG8_STAGE(PG8_SB(1, 1), b3 + hstepB, voffB);
            PG8_WAIT_V(6); PG8_BAR; PG8_MMA(1, 1, At, B1); PG8_BAR;
            }
        }
        if constexpr (ALIGN_EPI) { if (wr == 0) PG8_BAR; }
        int l2 = lane; asm volatile("" : "+v"(l2));
        const bool keep = E(acc, cur, wr, wc, l2 & 15, l2 >> 4);
        if (!has_next) break;
        if (!keep) {
#pragma unroll
        for (int a = 0; a < 2; ++a)
#pragma unroll
            for (int b = 0; b < 2; ++b)
#pragma unroll
                for (int m = 0; m < 4; ++m)
#pragma unroll
                    for (int n = 0; n < 2; ++n) acc[a][b][m][n] = (f32x4){0.f, 0.f, 0.f, 0.f};
        }
        cur = nxt; cA = nA; cB = nB; ++ui;
        if constexpr (ALIGN_EPI) { if (wr == 1) PG8_BAR; }
    }
    PG8_WAIT_V(0);
    if constexpr (!ALIGN_EPI) { if (wr == 0) PG8_BAR; }
    PG8_BAR;
#undef PG8_SA
#undef PG8_SB
#undef PG8_STAGE
#undef PG8_LDA
#undef PG8_LDB
#undef PG8_MMA
#undef PG8_WAIT_V
#undef PG8_WAIT_L
#undef PG8_BAR
#undef PG8_SCHED
}
}

#define XB_TMO      128
#define XB_XCNT(j)  (256  + 64 * (j))
#define XB_XSUB(j)  (1280 + 64 * (j))
#define XB_XGEN(j)  (2304 + 64 * (j))
#define XB_TOP      3328
#define XB_TOPGEN   3392
#define XCD_BAR_WORDS 3456
#define XB_SPIN_CAP (1u << 20)
__device__ __forceinline__ unsigned xb_ld(unsigned* p)              { return __hip_atomic_load(p, __ATOMIC_RELAXED, __HIP_MEMORY_SCOPE_AGENT); }
__device__ __forceinline__ unsigned xb_add(unsigned* p, unsigned v) { return __hip_atomic_fetch_add(p, v, __ATOMIC_RELAXED, __HIP_MEMORY_SCOPE_AGENT); }
__device__ __forceinline__ unsigned xb_xcc_id() { return (unsigned)__builtin_amdgcn_s_getreg((3 << 11) | 20) & 0xFu; }
#define XB_SPIN(cond, bar) do { unsigned _sp = 0; while (cond) { __builtin_amdgcn_s_sleep(1); \
    if ((++_sp & 255u) == 0u) { if (xb_ld(&(bar)[XB_TMO])) break; if (_sp > XB_SPIN_CAP) { atomicAdd(&(bar)[XB_TMO], 1u); break; } } } } while (0)
struct XcdBarrier { unsigned* bar; unsigned x; volatile LAS unsigned* st; };
__device__ __forceinline__ XcdBarrier xcd_barrier_post(unsigned* bar, volatile LAS unsigned* st) {
    XcdBarrier b; b.bar = bar; b.x = xb_xcc_id(); b.st = st;
    if (threadIdx.x == 0) (void)xb_add(&bar[XB_XCNT(b.x)], 1u);
    return b;
}
__device__ __forceinline__ void xcd_barrier_complete(unsigned* bar, unsigned x, unsigned& nloc, unsigned& nx) {
    const unsigned G = gridDim.x * gridDim.y * gridDim.z;
    unsigned sum, cnt, mine, sp = 0u;
    for (;;) {
        sum = 0u; cnt = 0u; mine = 0u;
#pragma unroll
        for (unsigned j = 0; j < 16; ++j) { const unsigned c = xb_ld(&bar[XB_XCNT(j)]); sum += c; cnt += (c > 0u) ? 1u : 0u; mine = (j == x) ? c : mine; }
        if (sum == G) break;
        __builtin_amdgcn_s_sleep(1);
        if ((++sp & 255u) == 0u) { if (xb_ld(&bar[XB_TMO])) break; if (sp > XB_SPIN_CAP) { atomicAdd(&bar[XB_TMO], 1u); break; } }
    }
    nloc = mine > 0u ? mine : 1u; nx = cnt > 0u ? cnt : 1u;
}
__device__ __forceinline__ void xcd_barrier(const XcdBarrier& b) {
    asm volatile("s_waitcnt vmcnt(0)" ::: "memory");
    __syncthreads();
    if (threadIdx.x == 0) {
        unsigned* bar = b.bar;
        __builtin_amdgcn_s_waitcnt(0);
        unsigned nloc = b.st[0], nx = b.st[1];
        if (nloc == 0u) { xcd_barrier_complete(bar, b.x, nloc, nx); b.st[0] = nloc; b.st[1] = nx; }
        const unsigned old = xb_add(&bar[XB_XSUB(b.x)], 1u);
        const unsigned gen = old / nloc;
        if (old + 1u == (gen + 1u) * nloc) {
            __builtin_amdgcn_fence(__ATOMIC_RELEASE, "agent");
            asm volatile("s_waitcnt vmcnt(0)" ::: "memory");
            const unsigned og = xb_add(&bar[XB_TOP], 1u);
            const unsigned tg = og / nx;
            if (og + 1u == (tg + 1u) * nx) xb_add(&bar[XB_TOPGEN], 1u);
            else XB_SPIN(xb_ld(&bar[XB_TOPGEN]) == tg, bar);
            __builtin_amdgcn_fence(__ATOMIC_ACQUIRE, "agent");
            xb_add(&bar[XB_XGEN(b.x)], 1u);
            asm volatile("s_waitcnt vmcnt(0)" ::: "memory");
        } else {
            XB_SPIN(xb_ld(&bar[XB_XGEN(b.x)]) == gen, bar);
            __builtin_amdgcn_fence(__ATOMIC_ACQUIRE, "agent");
            asm volatile("s_waitcnt vmcnt(0)" ::: "memory");
        }
    }
    __syncthreads();
}

constexpr int NWAVES = 8, NTHREADS = 512;
constexpr int RING_BYTES = 131072, LDSCTL_OFF = RING_BYTES, MISC_OFF = LDSCTL_OFF + 320, LDS_BYTES = 147456;
constexpr int N1 = 5120;
constexpr size_t WS_CTL = 0, CTL_ZERO_BYTES = 256 * 1024;
constexpr int CW_BAR = 1024;
constexpr size_t WS_WIN = 1 * MiB  , WS_WOA = 11 * MiB, WS_WOB = 12 * MiB, WS_WOUT = 13 * MiB  ;
#define LDS_WAIT() asm volatile("s_waitcnt lgkmcnt(0)" ::: "memory")
constexpr size_t WS_HG = 16 * MiB, WS_YE = 16 * MiB, WS_ACT = 96 * MiB, WS_WGU = 176 * MiB, WS_WD = 208 * MiB, WS_H2M = 224 * MiB;
constexpr size_t WS_SELE = 15 * MiB, WS_SELW = WS_SELE + 128 * 1024, WS_SELP = WS_SELW + 128 * 1024, WS_ROW = WS_SELP + 128 * 1024;
constexpr int CW_GQ = 448;
constexpr int CW_CNT = 512;
constexpr int TAB_OFF = LDSCTL_OFF + 1024;

enum { PH_P0 = 0, PH_GEMM1, PH_PREP, PH_SCAN1, PH_SCAN2, PH_SCAN3, PH_MIX, PH_WOUT, PH_ROUTER, PH_GATHER, PH_MOE1, PH_MOE2, PH_FINAL, PH_END };
struct Args { const float* in[31]; float* out; unsigned char* ws; int ph_lo, ph_hi, li, pad; };

struct Frame { LAS unsigned char* lds; int wave, vcu, G; };
__device__ __forceinline__ int opaque_tid() { int t = threadIdx.x; asm volatile("" : "+v"(t)); return t; }
#define F_LANE (opaque_tid() & 63)
#define F_TID (opaque_tid())

__device__ __forceinline__ unsigned pk2(float lo, float hi) { return (unsigned)f2bf(lo) | ((unsigned)f2bf(hi) << 16); }
__device__ __forceinline__ void p0_transpose_item(const float* __restrict__ W, int K, int N, bf16* WT, int ldt, int row_off, LAS float* scr, int kb, int nb, int lane) {
    const int k0 = 64 * kb, n0 = 32 * nb;
#pragma unroll 8
    for (int i = 0; i < 32; ++i) { const int kk = 2 * i + (lane >> 5); scr[kk * 33 + (lane & 31)] = W[(size_t)(k0 + kk) * N + n0 + (lane & 31)]; }
    LDS_WAIT(); asm volatile("" ::: "memory");
    const int c = lane & 7;
#pragma unroll
    for (int j = 0; j < 4; ++j) { const int n = (lane >> 3) + 8 * j; const LAS float* s = scr + (8 * c) * 33 + n;
        u32x4 o; o.x = pk2(s[0 * 33], s[1 * 33]); o.y = pk2(s[2 * 33], s[3 * 33]); o.z = pk2(s[4 * 33], s[5 * 33]); o.w = pk2(s[6 * 33], s[7 * 33]);
        *(u32x4*)(WT + (size_t)(row_off + n0 + n) * ldt + k0 + 8 * c) = o; }
    LDS_WAIT(); asm volatile("" ::: "memory");
}

struct Epi1 {
    static constexpr bool PERM = true;
    bf16* PA; bf16* ZB; bf16* GT; const float* b_gate;
    __device__ __forceinline__ bool operator()(f32x4 (&acc)[2][2][4][2], const pg8::Unit& u, int wr, int wc, int fr, int fq) const {
        const int row0 = u.pm * 256 + wr * 64 + fr;
        int mode, ldc, colt; bf16* base;
        if (u.pn < 8) { mode = 0; base = PA; ldc = PA_LD; colt = u.pn * 256; }
        else if (u.pn < 12) { mode = 1; base = ZB; ldc = 1024; colt = (u.pn - 8) * 256; }
        else { mode = 2; base = GT; ldc = 2048; colt = (u.pn - 12) * 256; }
        const int col0 = colt + wc * 32 + 8 * fq;
        f32x4 bv[2][2];
#pragma unroll
        for (int bj = 0; bj < 2; ++bj)
#pragma unroll
            for (int n = 0; n < 2; ++n) bv[bj][n] = (mode == 2) ? *(const f32x4*)(b_gate + col0 + bj * 128 + 4 * n) : (f32x4){0.f, 0.f, 0.f, 0.f};
#pragma unroll
        for (int ai = 0; ai < 2; ++ai)
#pragma unroll
            for (int m = 0; m < 4; ++m) { bf16* rowp = base + (size_t)(row0 + ai * 128 + m * 16) * ldc + col0;
#pragma unroll
                for (int bj = 0; bj < 2; ++bj) { f32x4 v0 = acc[ai][bj][m][0] + bv[bj][0], v1 = acc[ai][bj][m][1] + bv[bj][1];
                    if (mode == 1) { f32x2 a = pg8::gelu_pk((f32x2){v0[0], v0[1]}), b = pg8::gelu_pk((f32x2){v0[2], v0[3]}), c = pg8::gelu_pk((f32x2){v1[0], v1[1]}), d = pg8::gelu_pk((f32x2){v1[2], v1[3]});
                        v0 = (f32x4){a.x, a.y, b.x, b.y}; v1 = (f32x4){c.x, c.y, d.x, d.y}; }
                    if (mode == 2) {
#pragma unroll
                        for (int j = 0; j < 4; ++j) { v0[j] = pg8::fast_sigmoid(v0[j]); v1[j] = pg8::fast_sigmoid(v1[j]); } }
                    u32x4 w; w.x = pg8::cvt_pk_bf16(v0[0], v0[1]); w.y = pg8::cvt_pk_bf16(v0[2], v0[3]); w.z = pg8::cvt_pk_bf16(v1[0], v1[1]); w.w = pg8::cvt_pk_bf16(v1[2], v1[3]);
                    *(u32x4*)(rowp + bj * 128) = w; } }
        return false;
    }
};

struct MixOrder {
    const char *YA, *YB, *WA, *WB; int G, c;
    __device__ __forceinline__ bool next(int i, pg8::Unit& u) const {
        const int L = (i >> 1) * G + c; if (L >= 256) return false;
        pg8::tile_order(L, 64, 4, u.pm, u.pn); u.aux = i & 1;
        u.A = ((i & 1) ? YB : YA) + (size_t)u.pm * 256 * 512 * 2; u.B = ((i & 1) ? WB : WA) + (size_t)u.pn * 256 * 512 * 2; return true;
    }
};
__device__ __forceinline__ void unpack8(const u32x4 w, float (&f)[8]) {
    f[0] = __uint_as_float(w.x << 16); f[1] = __uint_as_float(w.x & 0xffff0000u); f[2] = __uint_as_float(w.y << 16); f[3] = __uint_as_float(w.y & 0xffff0000u);
    f[4] = __uint_as_float(w.z << 16); f[5] = __uint_as_float(w.z & 0xffff0000u); f[6] = __uint_as_float(w.w << 16); f[7] = __uint_as_float(w.w & 0xffff0000u);
}
struct EpiMix {
    static constexpr bool PERM = true;
    const bf16* GT; bf16* MIX;
    __device__ __forceinline__ bool operator()(f32x4 (&acc)[2][2][4][2], const pg8::Unit& u, int wr, int wc, int fr, int fq) const {
        const int row0 = u.pm * 256 + wr * 64 + fr, col0 = u.pn * 256 + wc * 32 + 8 * fq;
#pragma unroll
        for (int ai = 0; ai < 2; ++ai)
#pragma unroll
            for (int m = 0; m < 4; ++m) { const size_t row = (size_t)(row0 + ai * 128 + m * 16);
#pragma unroll
                for (int bj = 0; bj < 2; ++bj) { const int c = col0 + bj * 128;
                    float gb[8]; unpack8(*(const u32x4*)(GT + row * 2048 + 1024 + c), gb);
                    if (u.aux == 0) { float ga[8]; unpack8(*(const u32x4*)(GT + row * 2048 + c), ga);
#pragma unroll
                        for (int j = 0; j < 4; ++j) { acc[ai][bj][m][0][j] *= ga[j] * __builtin_amdgcn_rcpf(gb[j]); acc[ai][bj][m][1][j] *= ga[4 + j] * __builtin_amdgcn_rcpf(gb[4 + j]); }
                    } else { const f32x4 v0 = acc[ai][bj][m][0], v1 = acc[ai][bj][m][1];
                        u32x4 w; w.x = pg8::cvt_pk_bf16(v0[0] * gb[0], v0[1] * gb[1]); w.y = pg8::cvt_pk_bf16(v0[2] * gb[2], v0[3] * gb[3]);
                        w.z = pg8::cvt_pk_bf16(v1[0] * gb[4], v1[1] * gb[5]); w.w = pg8::cvt_pk_bf16(v1[2] * gb[6], v1[3] * gb[7]);
                        *(u32x4*)(MIX + row * 1024 + c) = w; } } }
        return u.aux == 0;
    }
};
struct EpiX1 {
    static constexpr bool PERM = false;
    const float* x; float* X1;
    __device__ __forceinline__ bool operator()(f32x4 (&acc)[2][2][4][2], const pg8::Unit& u, int wr, int wc, int fr, int fq) const {
        const int row0 = u.pm * 256 + wr * 64 + fr, col0 = u.pn * 256 + wc * 32 + 4 * fq;
#pragma unroll
        for (int ai = 0; ai < 2; ++ai)
#pragma unroll
            for (int m = 0; m < 4; ++m) { const size_t off = (size_t)(row0 + ai * 128 + m * 16) * 1024 + col0;
#pragma unroll
                for (int bj = 0; bj < 2; ++bj)
#pragma unroll
                    for (int n = 0; n < 2; ++n) *(f32x4*)(X1 + off + bj * 128 + n * 16) = *(const f32x4*)(x + off + bj * 128 + n * 16) + acc[ai][bj][m][n]; }
        return false;
    }
};

__device__ __forceinline__ void moe_tables(Frame& F, const unsigned* cnt) {
    volatile LAS int* tab = (volatile LAS int*)(F.lds + TAB_OFF);
    if (F_TID == 0) { int acc = 0; for (int e = 0; e < 32; ++e) { tab[e] = acc; acc += (int)((__hip_atomic_load(cnt + e, __ATOMIC_RELAXED, __HIP_MEMORY_SCOPE_AGENT) + 255u) >> 8); } tab[32] = acc; }
    __syncthreads();
}
struct MoeOrder {
    const char* A; const char* B; LAS const int* tab; int NT, nN, G, c; size_t a_tile, b_exp, b_tile;
    __device__ __forceinline__ bool next(int i, pg8::Unit& u) const {
        const int L = i * G + c; if (L >= NT * nN) return false;
        pg8::tile_order(L, NT, nN, u.pm, u.pn);
        int e = 0;
#pragma unroll 1
        for (int k = 1; k < 32; ++k) e += (u.pm >= tab[k]) ? 1 : 0;
        u.aux = e; u.A = A + (size_t)u.pm * a_tile; u.B = B + (size_t)e * b_exp + (size_t)u.pn * b_tile; return true;
    }
};
struct EpiAct {
    static constexpr bool PERM = true;
    bf16* ACT;
    __device__ __forceinline__ bool operator()(f32x4 (&acc)[2][2][4][2], const pg8::Unit& u, int wr, int wc, int fr, int fq) const {
        const int row0 = u.pm * 256 + wr * 64 + fr, col0 = u.pn * 128 + wc * 32 + 8 * fq;
#pragma unroll
        for (int ai = 0; ai < 2; ++ai)
#pragma unroll
            for (int m = 0; m < 4; ++m) { float o[8];
#pragma unroll
                for (int n = 0; n < 2; ++n)
#pragma unroll
                    for (int j = 0; j < 4; ++j) { const float g = acc[ai][0][m][n][j], up = acc[ai][1][m][n][j]; o[4 * n + j] = g * pg8::fast_sigmoid(g) * up; }
                u32x4 w; w.x = pg8::cvt_pk_bf16(o[0], o[1]); w.y = pg8::cvt_pk_bf16(o[2], o[3]); w.z = pg8::cvt_pk_bf16(o[4], o[5]); w.w = pg8::cvt_pk_bf16(o[6], o[7]);
                *(u32x4*)(ACT + (size_t)(row0 + ai * 128 + m * 16) * 256 + col0) = w; }
        return false;
    }
};
struct EpiYE {
    static constexpr bool PERM = true;
    bf16* YE;
    __device__ __forceinline__ bool operator()(f32x4 (&acc)[2][2][4][2], const pg8::Unit& u, int wr, int wc, int fr, int fq) const {
        const int row0 = u.pm * 256 + wr * 64 + fr, col0 = u.pn * 256 + wc * 32 + 8 * fq;
#pragma unroll
        for (int ai = 0; ai < 2; ++ai)
#pragma unroll
            for (int m = 0; m < 4; ++m) { bf16* rowp = YE + (size_t)(row0 + ai * 128 + m * 16) * 1024 + col0;
#pragma unroll
                for (int bj = 0; bj < 2; ++bj) { const f32x4 v0 = acc[ai][bj][m][0], v1 = acc[ai][bj][m][1];
                    u32x4 w; w.x = pg8::cvt_pk_bf16(v0[0], v0[1]); w.y = pg8::cvt_pk_bf16(v0[2], v0[3]); w.z = pg8::cvt_pk_bf16(v1[0], v1[1]); w.w = pg8::cvt_pk_bf16(v1[2], v1[3]);
                    *(u32x4*)(rowp + bj * 128) = w; } }
        return false;
    }
};

constexpr size_t WS_PHIT = 16 * MiB, WS_QT = 32 * MiB, WS_LT = 48 * MiB, WS_YL = 64 * MiB;
__device__ __forceinline__ float bflo(unsigned w) { return __uint_as_float(w << 16); }
__device__ __forceinline__ float bfhi(unsigned w) { return __uint_as_float(w & 0xffff0000u); }
struct ScanBufs { const bf16 *R, *KK, *BV, *KM, *LW, *VV, *GG; bf16 *PHIT, *QT, *LT, *YL; bf16 *XF; bf16* YA; };

typedef _Float16 h2_t __attribute__((ext_vector_type(2)));
__device__ __forceinline__ unsigned pkh(float a, float b) { h2_t v = {(_Float16)a, (_Float16)b}; return __builtin_bit_cast(unsigned, v); }
__device__ __forceinline__ float h_lo(unsigned w) { return (float)__builtin_bit_cast(h2_t, w)[0]; }
__device__ __forceinline__ float h_hi(unsigned w) { return (float)__builtin_bit_cast(h2_t, w)[1]; }
#define WKV_HPAIR2(P0, P1, L0, L1, E0, E1, B0, B1, K0, K1, R0, R1, A0, A1) \
    asm volatile( \
        "v_pk_fma_f16 %0, %0, %8, %0\n\tv_pk_fma_f16 %2, %2, %8, %2\n\tv_pk_fma_f16 %1, %1, %9, %1\n\tv_pk_fma_f16 %3, %3, %9, %3\n\t" \
        "v_pk_fma_f16 %0, %10, %18, %0\n\tv_pk_fma_f16 %2, %10, %19, %2\n\tv_pk_fma_f16 %1, %11, %18, %1\n\tv_pk_fma_f16 %3, %11, %19, %3\n\t" \
        "v_pk_fma_f16 %2, %12, %20, %2\n\tv_pk_fma_f16 %3, %13, %20, %3\n\t" \
        "v_pk_fma_f16 %4, %0, %14, %4\n\tv_pk_fma_f16 %6, %0, %16, %6\n\tv_pk_fma_f16 %5, %2, %14, %5\n\tv_pk_fma_f16 %7, %2, %16, %7\n\t" \
        "v_pk_fma_f16 %4, %1, %15, %4\n\tv_pk_fma_f16 %6, %1, %17, %6\n\tv_pk_fma_f16 %5, %3, %15, %5\n\tv_pk_fma_f16 %7, %3, %17, %7" \
        : "+v"(P0), "+v"(P1), "+v"(L0), "+v"(L1), "+v"(q), "+v"(yl), "+v"(sa2p), "+v"(sa2l) \
        : "v"(E0), "v"(E1), "v"(B0), "v"(B1), "v"(K0), "v"(K1), "v"(R0), "v"(R1), "v"(A0), "v"(A1), "v"(sap2), "v"(sal2), "v"(vv2))

__device__ __forceinline__ void scan_pass1_h(Frame& F, const ScanBufs& B) {
    LAS unsigned char* wl = F.lds + F.wave * 8192;
    const int lane = F_LANE, h = F.wave;
    for (int bc = F.vcu; bc < 256; bc += F.G) {
        const int b = bc >> 5, c = bc & 31; const size_t m0 = (size_t)b * T + c * 64; const int uid = (b * 8 + h) * 32 + c;
        unsigned phi[32], l[32]; unsigned one = 0x3C00u; asm volatile("" : "+v"(one));
#pragma unroll
        for (int p = 0; p < 32; ++p) { phi[p] = (lane == 2 * p ? one : 0u) | (lane == 2 * p + 1 ? (one << 16) : 0u); l[p] = 0u; }
        float sa_p = -bf2f(B.KK[m0 * AW + h * 64 + lane]), sa_l = 0.f;
        const int ts = lane >> 3, c0 = 8 * (lane & 7);
        const size_t goff = (m0 + ts) * AW + h * 64 + c0;
        u32x4 pr[6];
        pr[0] = *(const u32x4*)(B.LW + goff); pr[1] = *(const u32x4*)(B.BV + goff); pr[2] = *(const u32x4*)(B.KM + goff); pr[3] = *(const u32x4*)(B.R + goff);
        pr[4] = *(const u32x4*)(B.KK + goff + AW); pr[5] = *(const u32x4*)(B.VV + goff);
        for (int sb = 0; sb < 8; ++sb) {
            asm volatile("" ::: "memory");
#pragma unroll
            for (int v = 0; v < 5; ++v) { float f[8]; unpack8(pr[v], f);
                if (v == 0) {
#pragma unroll
                    for (int i = 0; i < 8; ++i) f[i] = __expf(f[i]) - 1.f; }
                if (v == 4) {
#pragma unroll
                    for (int i = 0; i < 8; ++i) f[i] = -f[i]; }
                *(LAS u32x4*)(wl + (v * 8 + ts) * 128 + 2 * c0) = (u32x4){pkh(f[0], f[1]), pkh(f[2], f[3]), pkh(f[4], f[5]), pkh(f[6], f[7])}; }
            { float f[8]; unpack8(pr[5], f); LAS u32x4* dst = (LAS u32x4*)(wl + 5120 + (ts * 64 + c0) * 4);
              dst[0] = (u32x4){pkh(f[0], f[0]), pkh(f[1], f[1]), pkh(f[2], f[2]), pkh(f[3], f[3])}; dst[1] = (u32x4){pkh(f[4], f[4]), pkh(f[5], f[5]), pkh(f[6], f[6]), pkh(f[7], f[7])}; }
            asm volatile("" ::: "memory");
            if (sb < 7) { const size_t g2 = goff + (size_t)(sb + 1) * 8 * AW;
                pr[0] = *(const u32x4*)(B.LW + g2); pr[1] = *(const u32x4*)(B.BV + g2); pr[2] = *(const u32x4*)(B.KM + g2); pr[3] = *(const u32x4*)(B.R + g2);
                pr[4] = *(const u32x4*)(B.KK + g2 + AW); pr[5] = *(const u32x4*)(B.VV + g2); }
#pragma unroll 1
            for (int tt = 0; tt < 8; ++tt) {
                const LAS unsigned char* vb = wl + tt * 128;
                const unsigned vv2 = *(const LAS unsigned*)(wl + 5120 + (tt * 64 + lane) * 4);
                const unsigned sap2 = pkh(sa_p, sa_p), sal2 = pkh(sa_l, sa_l);
                unsigned q = 0u, yl = 0u, sa2p = 0u, sa2l = 0u;
                u32x4 ve = *(const LAS u32x4*)(vb), vbb = *(const LAS u32x4*)(vb + 1024), vk = *(const LAS u32x4*)(vb + 2048), vr = *(const LAS u32x4*)(vb + 3072), va = *(const LAS u32x4*)(vb + 4096);
#pragma unroll
                for (int g = 0; g < 8; ++g) {
                    u32x4 ne, nb, nk, nr, na;
                    if (g < 7) { ne = *(const LAS u32x4*)(vb + 16 * g + 16); nb = *(const LAS u32x4*)(vb + 1024 + 16 * g + 16); nk = *(const LAS u32x4*)(vb + 2048 + 16 * g + 16);
                                 nr = *(const LAS u32x4*)(vb + 3072 + 16 * g + 16); na = *(const LAS u32x4*)(vb + 4096 + 16 * g + 16); }
                    __builtin_amdgcn_sched_barrier(0);
                    WKV_HPAIR2(phi[4 * g], phi[4 * g + 1], l[4 * g], l[4 * g + 1], ve[0], ve[1], vbb[0], vbb[1], vk[0], vk[1], vr[0], vr[1], va[0], va[1]);
                    WKV_HPAIR2(phi[4 * g + 2], phi[4 * g + 3], l[4 * g + 2], l[4 * g + 3], ve[2], ve[3], vbb[2], vbb[3], vk[2], vk[3], vr[2], vr[3], va[2], va[3]);
                    __builtin_amdgcn_sched_barrier(0);
                    if (g < 7) { ve = ne; vbb = nb; vk = nk; vr = nr; va = na; }
                }
                const int t = sb * 8 + tt;
                B.QT[(size_t)uid * 4096 + t * 64 + lane] = f2bf(h_lo(q) + h_hi(q));
                B.YL[(size_t)uid * 4096 + t * 64 + lane] = f2bf(h_lo(yl) + h_hi(yl));
                sa_p = h_lo(sa2p) + h_hi(sa2p); sa_l = h_lo(sa2l) + h_hi(sa2l);
            }
        }
#pragma unroll
        for (int p = 0; p < 32; ++p) { const size_t o = (size_t)uid * 4096 + (2 * p) * 64 + lane;
            B.PHIT[o] = f2bf(h_lo(phi[p])); B.PHIT[o + 64] = f2bf(h_hi(phi[p])); B.LT[o] = f2bf(h_lo(l[p])); B.LT[o + 64] = f2bf(h_hi(l[p])); }
    }
}

typedef float f32x16 __attribute__((ext_vector_type(16)));
__device__ __forceinline__ bf16x8 acc_frag(const f32x16& x, int s) {
    u32x4 w; w.x = pg8::cvt_pk_bf16(x[8 * s], x[8 * s + 1]); w.y = pg8::cvt_pk_bf16(x[8 * s + 2], x[8 * s + 3]); w.z = pg8::cvt_pk_bf16(x[8 * s + 4], x[8 * s + 5]); w.w = pg8::cvt_pk_bf16(x[8 * s + 6], x[8 * s + 7]);
    return __builtin_bit_cast(bf16x8, w);
}
__device__ __forceinline__ bf16x8 row_frag(const bf16* row, int s, int hh) {
    const u32x2 a = *(const u32x2*)(row + 16 * s + 4 * hh), b = *(const u32x2*)(row + 16 * s + 8 + 4 * hh);
    u32x4 w; w.x = a.x; w.y = a.y; w.z = b.x; w.w = b.y; return __builtin_bit_cast(bf16x8, w);
}
__device__ __forceinline__ void scan_pass2(Frame& F, const ScanBufs& B) {
    if (F.wave >= 2) return;
    const int it = F.wave, lane = F_LANE, l31 = lane & 31, hh = lane >> 5;
    for (int bh = F.vcu; bh < 64; bh += F.G) {
        f32x16 X[2];
#pragma unroll
        for (int jt = 0; jt < 2; ++jt)
#pragma unroll
            for (int r = 0; r < 16; ++r) X[jt][r] = 0.f;
        f32x16 Ln[2]; bf16x8 Pf[2][2][2];
#define P2_LOAD(c_) do { const size_t ub_ = ((size_t)bh * 32 + (c_)) * 4096; \
            _Pragma("unroll") for (int j2 = 0; j2 < 2; ++j2) { \
                _Pragma("unroll") for (int r = 0; r < 16; ++r) Ln[j2][r] = bf2f(B.LT[ub_ + (size_t)(32 * j2 + (r & 3) + 8 * (r >> 2) + 4 * hh) * 64 + 32 * it + l31]); \
                const bf16* prow_ = B.PHIT + ub_ + (size_t)(32 * j2 + l31) * 64; \
                _Pragma("unroll") for (int jt = 0; jt < 2; ++jt) _Pragma("unroll") for (int s = 0; s < 2; ++s) Pf[j2][jt][s] = row_frag(prow_ + 32 * jt, s, hh); } } while (0)
        P2_LOAD(0);
#pragma unroll 1
        for (int c = 0; c < 32; ++c) { const size_t ub = ((size_t)bh * 32 + c) * 4096;
            bf16x8 xf[2][2];
#pragma unroll
            for (int jt = 0; jt < 2; ++jt)
#pragma unroll
                for (int s = 0; s < 2; ++s) { xf[jt][s] = acc_frag(X[jt], s);
                    *(bf16x8*)(B.XF + ub + (size_t)(((it * 2 + jt) * 2 + s) * 64 + lane) * 8) = xf[jt][s]; }
            f32x16 Xn[2] = {Ln[0], Ln[1]}; bf16x8 Pc[2][2][2];
#pragma unroll
            for (int j2 = 0; j2 < 2; ++j2)
#pragma unroll
                for (int jt = 0; jt < 2; ++jt)
#pragma unroll
                    for (int s = 0; s < 2; ++s) Pc[j2][jt][s] = Pf[j2][jt][s];
            if (c < 31) P2_LOAD(c + 1);
#pragma unroll
            for (int j2 = 0; j2 < 2; ++j2)
#pragma unroll
                for (int jt = 0; jt < 2; ++jt)
#pragma unroll
                    for (int s = 0; s < 2; ++s) Xn[j2] = __builtin_amdgcn_mfma_f32_32x32x16_bf16(Pc[j2][jt][s], xf[jt][s], Xn[j2], 0, 0, 0);
            X[0] = Xn[0]; X[1] = Xn[1];
        }
#undef P2_LOAD
    }
}
__device__ __forceinline__ void scan_pass3(Frame& F, const ScanBufs& B, const float* __restrict__ r_k, const float* __restrict__ lnx_g, const float* __restrict__ lnx_b) {
    const int lane = F_LANE, l31 = lane & 31, hh = lane >> 5, h = F.wave;
    for (int bc = F.vcu; bc < 256; bc += F.G) {
        const int b = bc >> 5, c = bc & 31; const size_t m0 = (size_t)b * T + c * 64; const size_t ub = ((size_t)(b * 8 + h) * 32 + c) * 4096;
        bf16x8 xa[2][2][2];
#pragma unroll
        for (int it = 0; it < 2; ++it)
#pragma unroll
            for (int jt = 0; jt < 2; ++jt)
#pragma unroll
                for (int s = 0; s < 2; ++s) xa[it][jt][s] = *(const bf16x8*)(B.XF + ub + (size_t)(((it * 2 + jt) * 2 + s) * 64 + lane) * 8);
#pragma unroll 1
        for (int tt = 0; tt < 2; ++tt) { const int t = 32 * tt + l31; const size_t m = m0 + t;
            f32x16 Y[2];
#pragma unroll
            for (int it = 0; it < 2; ++it)
#pragma unroll
                for (int g4 = 0; g4 < 4; ++g4) { const u32x2 y4 = *(const u32x2*)(B.YL + ub + (size_t)t * 64 + 32 * it + 8 * g4 + 4 * hh);
                    Y[it][4 * g4] = bflo(y4.x); Y[it][4 * g4 + 1] = bfhi(y4.x); Y[it][4 * g4 + 2] = bflo(y4.y); Y[it][4 * g4 + 3] = bfhi(y4.y); }
            const bf16* qrow = B.QT + ub + (size_t)t * 64;
#pragma unroll
            for (int jt = 0; jt < 2; ++jt)
#pragma unroll
                for (int s = 0; s < 2; ++s) { const bf16x8 qb = row_frag(qrow + 32 * jt, s, hh);
#pragma unroll
                    for (int it = 0; it < 2; ++it) Y[it] = __builtin_amdgcn_mfma_f32_32x32x16_bf16(xa[it][jt][s], qb, Y[it], 0, 0, 0); }
            float sum = 0.f;
#pragma unroll
            for (int it = 0; it < 2; ++it)
#pragma unroll
                for (int r = 0; r < 16; ++r) sum += Y[it][r];
            sum += __shfl_xor(sum, 32);
            const float mean = sum * (1.f / 64.f); float sq = 0.f;
#pragma unroll
            for (int it = 0; it < 2; ++it)
#pragma unroll
                for (int r = 0; r < 16; ++r) { const float d = Y[it][r] - mean; sq += d * d; }
            sq += __shfl_xor(sq, 32);
            const float rstd = rsqrtf(sq * (1.f / 64.f) + 64e-5f);
            float bsum = 0.f;
#pragma unroll
            for (int it = 0; it < 2; ++it)
#pragma unroll
                for (int g4 = 0; g4 < 4; ++g4) { const int ch = h * 64 + 32 * it + 8 * g4 + 4 * hh; const size_t o = m * AW + ch;
                    const u32x2 r2 = *(const u32x2*)(B.R + o), k2 = *(const u32x2*)(B.KM + o);
                    const f32x4 rk = *(const f32x4*)(r_k + ch);
                    const float r0 = __uint_as_float(r2.x << 16), r1 = __uint_as_float(r2.x & 0xffff0000u), r2f = __uint_as_float(r2.y << 16), r3 = __uint_as_float(r2.y & 0xffff0000u);
                    const float k0 = __uint_as_float(k2.x << 16), k1 = __uint_as_float(k2.x & 0xffff0000u), k2f = __uint_as_float(k2.y << 16), k3 = __uint_as_float(k2.y & 0xffff0000u);
                    bsum += (r0 * k0 * rk.x + r1 * k1 * rk.y) + (r2f * k2f * rk.z + r3 * k3 * rk.w); }
            bsum += __shfl_xor(bsum, 32);
            asm volatile("" : "+v"(bsum));
#pragma unroll
            for (int it = 0; it < 2; ++it)
#pragma unroll
                for (int g4 = 0; g4 < 4; ++g4) { const int ch = h * 64 + 32 * it + 8 * g4 + 4 * hh; const size_t o = m * AW + ch;
                    const u32x2 v2 = *(const u32x2*)(B.VV + o), g2 = *(const u32x2*)(B.GG + o);
                    const f32x4 lg = *(const f32x4*)(lnx_g + ch), lb = *(const f32x4*)(lnx_b + ch);
                    const float vv[4] = {__uint_as_float(v2.x << 16), __uint_as_float(v2.x & 0xffff0000u), __uint_as_float(v2.y << 16), __uint_as_float(v2.y & 0xffff0000u)};
                    const float gg[4] = {__uint_as_float(g2.x << 16), __uint_as_float(g2.x & 0xffff0000u), __uint_as_float(g2.y << 16), __uint_as_float(g2.y & 0xffff0000u)};
                    float o4[4];
#pragma unroll
                    for (int i = 0; i < 4; ++i) { const float yn = (Y[it][4 * g4 + i] - mean) * rstd * lg[i] + lb[i]; o4[i] = (yn + bsum * vv[i]) * gg[i]; }
                    u32x2 w; w.x = pg8::cvt_pk_bf16(o4[0], o4[1]); w.y = pg8::cvt_pk_bf16(o4[2], o4[3]);
                    *(u32x2*)(B.YA + m * AW + ch) = w; }
        }
    }
}

constexpr size_t WS_WRT = 512 * 1024;
constexpr size_t WS_W2T = 15 * MiB + 512 * 1024, WS_A2T = WS_W2T + 64 * 1024, WS_G2T = WS_A2T + 64 * 1024, WS_WSB = WS_G2T + 160 * 1024;
constexpr int XS_LD = 296, VT_LD = 136;
struct PrepBufs { const bf16* PA; const float *mu, *w0, *a0, *k_k, *k_a; const bf16 *W2T, *A2T, *G2T; bf16 *R, *KK, *BV, *KM, *LW, *VV, *GG; };
__device__ __forceinline__ f32x4 lerp4(const bf16* cur, const float* mu, bool first) {
    const u32x2 c = *(const u32x2*)cur; u32x2 p = *(const u32x2*)(cur - PA_LD); if (first) { p.x = 0u; p.y = 0u; }
    const f32x4 m4 = *(const f32x4*)mu; const f32x4 cv = (f32x4){bflo(c.x), bfhi(c.x), bflo(c.y), bfhi(c.y)}, pv = (f32x4){bflo(p.x), bfhi(p.x), bflo(p.y), bfhi(p.y)};
    return cv + m4 * (pv - cv);
}
constexpr int LO_LD = 72;
__device__ __forceinline__ void prep_phase(Frame& F, const PrepBufs& P) {
    const int lane = F_LANE, tid = F_TID, l31 = lane & 31, hh = lane >> 5, h = F.wave;
    LAS bf16* xs = (LAS bf16*)F.lds;
    LAS bf16* lo = (LAS bf16*)(F.lds + 32 * XS_LD * 2) + h * (3 * 32 * LO_LD);
    const int chn = h * 64 + 8 * (lane & 7);
    for (int tl = 0; tl < 2 * ((M / 64 + F.G - 1) / F.G); ++tl) { const int u = F.vcu + (tl >> 1) * F.G; if (u >= M / 64) break; const size_t m0 = (size_t)(2 * u + (tl & 1)) * 32;
        __syncthreads();
        for (int it = tid; it < 32 * 36; it += NTHREADS) { const int tok = it / 36, c = it - tok * 36; const size_t m = m0 + tok; const bool first = (m & (T - 1)) == 0;
            const bf16* cp = P.PA + m * PA_LD + 1536 + 8 * c;
            float x[8], pv[8]; unpack8(*(const u32x4*)cp, x); unpack8(*(const u32x4*)(cp - PA_LD), pv);
            const f32x4 mu0 = *(const f32x4*)(P.mu + 1536 + 8 * c), mu1 = *(const f32x4*)(P.mu + 1536 + 8 * c + 4);
#pragma unroll
            for (int i = 0; i < 8; ++i) { const float p = first ? 0.f : pv[i]; x[i] += (i < 4 ? mu0[i & 3] : mu1[i & 3]) * (p - x[i]); }
            if (c < 8) {
#pragma unroll
                for (int i = 0; i < 8; ++i) x[i] = 1.f - 2.f * __builtin_amdgcn_rcpf(1.f + __builtin_amdgcn_exp2f(2.8853900817779268f * x[i])); }
            else if (c >= 16) {
#pragma unroll
                for (int i = 0; i < 8; ++i) x[i] = pg8::fast_sigmoid(x[i]); }
            u32x4 w; w.x = pg8::cvt_pk_bf16(x[0], x[1]); w.y = pg8::cvt_pk_bf16(x[2], x[3]); w.z = pg8::cvt_pk_bf16(x[4], x[5]); w.w = pg8::cvt_pk_bf16(x[6], x[7]);
            *(LAS u32x4*)(xs + tok * XS_LD + 8 * c) = w; }
        __syncthreads();
        const LAS bf16* xrow = xs + l31 * XS_LD + 8 * hh;
#pragma unroll
        for (int which = 0; which < 3; ++which) {
            f32x16 acc[2];
#pragma unroll
            for (int i2 = 0; i2 < 2; ++i2)
#pragma unroll
                for (int r = 0; r < 16; ++r) acc[i2][r] = 0.f;
            const bf16* WT = which == 0 ? P.A2T : (which == 1 ? P.W2T : P.G2T); const int ldw = which == 2 ? 160 : 64, nks = which == 2 ? 10 : 4, xoff = which == 0 ? 64 : (which == 1 ? 0 : 128);
#pragma unroll
            for (int ks = 0; ks < nks; ++ks) { const bf16x8 bx = *(const LAS bf16x8*)(xrow + xoff + 16 * ks);
#pragma unroll
                for (int i2 = 0; i2 < 2; ++i2) acc[i2] = __builtin_amdgcn_mfma_f32_32x32x16_bf16(*(const bf16x8*)(WT + (size_t)(h * 64 + 32 * i2 + l31) * ldw + 16 * ks + 8 * hh), bx, acc[i2], 0, 0, 0); }
#pragma unroll
            for (int i2 = 0; i2 < 2; ++i2)
#pragma unroll
                for (int g4 = 0; g4 < 4; ++g4) { const int cl = 32 * i2 + 8 * g4 + 4 * hh; float o4[4];
                    if (which == 0) { const f32x4 c4 = *(const f32x4*)(P.a0 + h * 64 + cl);
#pragma unroll
                        for (int i = 0; i < 4; ++i) o4[i] = pg8::fast_sigmoid(c4[i] + acc[i2][4 * g4 + i]); }
                    else if (which == 1) { const f32x4 c4 = *(const f32x4*)(P.w0 + h * 64 + cl);
#pragma unroll
                        for (int i = 0; i < 4; ++i) o4[i] = -0.60653066f * pg8::fast_sigmoid(c4[i] + acc[i2][4 * g4 + i]); }
                    else {
#pragma unroll
                        for (int i = 0; i < 4; ++i) o4[i] = acc[i2][4 * g4 + i]; }
                    u32x2 w; w.x = pg8::cvt_pk_bf16(o4[0], o4[1]); w.y = pg8::cvt_pk_bf16(o4[2], o4[3]);
                    *(LAS u32x2*)(lo + (which * 32 + l31) * LO_LD + cl) = w; }
        }
        asm volatile("s_waitcnt lgkmcnt(0)" ::: "memory");
        float muR[8], muK[8], muV[8], kk8[8], ka8[8];
        { const f32x4 a0_ = *(const f32x4*)(P.mu + chn), a1_ = *(const f32x4*)(P.mu + chn + 4), b0_ = *(const f32x4*)(P.mu + 512 + chn), b1_ = *(const f32x4*)(P.mu + 512 + chn + 4),
                      c0_ = *(const f32x4*)(P.mu + 1024 + chn), c1_ = *(const f32x4*)(P.mu + 1024 + chn + 4), d0_ = *(const f32x4*)(P.k_k + chn), d1_ = *(const f32x4*)(P.k_k + chn + 4),
                      e0_ = *(const f32x4*)(P.k_a + chn), e1_ = *(const f32x4*)(P.k_a + chn + 4);
#pragma unroll
          for (int i = 0; i < 4; ++i) { muR[i] = a0_[i]; muR[4 + i] = a1_[i]; muK[i] = b0_[i]; muK[4 + i] = b1_[i]; muV[i] = c0_[i]; muV[4 + i] = c1_[i]; kk8[i] = d0_[i]; kk8[4 + i] = d1_[i]; ka8[i] = e0_[i]; ka8[4 + i] = e1_[i]; } }
#pragma unroll 1
        for (int i4 = 0; i4 < 4; ++i4) { const int tok = (lane >> 3) + 8 * i4; const size_t m = m0 + tok; const bool first = (m & (T - 1)) == 0;
            const bf16* cp = P.PA + m * PA_LD + chn;
            float r[8], k[8], v[8], pr[8], pk[8], pv[8];
            unpack8(*(const u32x4*)cp, r); unpack8(*(const u32x4*)(cp + 512), k); unpack8(*(const u32x4*)(cp + 1024), v);
            unpack8(*(const u32x4*)(cp - PA_LD), pr); unpack8(*(const u32x4*)(cp - PA_LD + 512), pk); unpack8(*(const u32x4*)(cp - PA_LD + 1024), pv);
            float a[8]; unpack8(*(const LAS u32x4*)(lo + tok * LO_LD + 8 * (lane & 7)), a);
            const u32x4 lwb = *(const LAS u32x4*)(lo + (32 + tok) * LO_LD + 8 * (lane & 7)), ggb = *(const LAS u32x4*)(lo + (64 + tok) * LO_LD + 8 * (lane & 7));
            float kkv[8]; float ss = 0.f;
#pragma unroll
            for (int i = 0; i < 8; ++i) { const float p0 = first ? 0.f : pr[i], p1 = first ? 0.f : pk[i], p2 = first ? 0.f : pv[i];
                r[i] += muR[i] * (p0 - r[i]); k[i] += muK[i] * (p1 - k[i]); v[i] += muV[i] * (p2 - v[i]); kkv[i] = k[i] * kk8[i]; ss += kkv[i] * kkv[i]; }
            ss += __shfl_xor(ss, 1); ss += __shfl_xor(ss, 2); ss += __shfl_xor(ss, 4);
            const float inv = 1.f / fmaxf(sqrtf(ss), 1e-12f);
            float bv[8], km[8];
#pragma unroll
            for (int i = 0; i < 8; ++i) { kkv[i] *= inv; bv[i] = kkv[i] * a[i]; km[i] = k[i] * (1.f + (a[i] - 1.f) * ka8[i]); }
            const size_t o = m * AW + chn; u32x4 w;
            w.x = pg8::cvt_pk_bf16(r[0], r[1]); w.y = pg8::cvt_pk_bf16(r[2], r[3]); w.z = pg8::cvt_pk_bf16(r[4], r[5]); w.w = pg8::cvt_pk_bf16(r[6], r[7]); *(u32x4*)(P.R + o) = w;
            w.x = pg8::cvt_pk_bf16(kkv[0], kkv[1]); w.y = pg8::cvt_pk_bf16(kkv[2], kkv[3]); w.z = pg8::cvt_pk_bf16(kkv[4], kkv[5]); w.w = pg8::cvt_pk_bf16(kkv[6], kkv[7]); *(u32x4*)(P.KK + o) = w;
            w.x = pg8::cvt_pk_bf16(bv[0], bv[1]); w.y = pg8::cvt_pk_bf16(bv[2], bv[3]); w.z = pg8::cvt_pk_bf16(bv[4], bv[5]); w.w = pg8::cvt_pk_bf16(bv[6], bv[7]); *(u32x4*)(P.BV + o) = w;
            w.x = pg8::cvt_pk_bf16(km[0], km[1]); w.y = pg8::cvt_pk_bf16(km[2], km[3]); w.z = pg8::cvt_pk_bf16(km[4], km[5]); w.w = pg8::cvt_pk_bf16(km[6], km[7]); *(u32x4*)(P.KM + o) = w;
            w.x = pg8::cvt_pk_bf16(v[0], v[1]); w.y = pg8::cvt_pk_bf16(v[2], v[3]); w.z = pg8::cvt_pk_bf16(v[4], v[5]); w.w = pg8::cvt_pk_bf16(v[6], v[7]); *(u32x4*)(P.VV + o) = w;
            *(u32x4*)(P.LW + o) = lwb; *(u32x4*)(P.GG + o) = ggb;
        }
    }
}
__device__ __forceinline__ void gmlp_phase(Frame& F, const bf16* __restrict__ ZB, const float* __restrict__ lnv_g, const float* __restrict__ lnv_b, const bf16* __restrict__ WSB, const float* __restrict__ b_s, bf16* YB, unsigned* queue) {
    const int lane = F_LANE, l31 = lane & 31, hh = lane >> 5, tid = F_TID;
    LAS bf16* vt = (LAS bf16*)F.lds;
    LAS float* st = (LAS float*)(F.lds + 128 * VT_LD * 2);
    volatile LAS int* qw = (volatile LAS int*)(F.lds + TAB_OFF + 192);
    for (;;) {
        __syncthreads();
        if (tid == 0) *qw = (int)__hip_atomic_fetch_add(queue, 1u, __ATOMIC_RELAXED, __HIP_MEMORY_SCOPE_AGENT);
        __syncthreads();
        const int unit = *qw; if (unit >= 512) break;
        const int g = unit & 3; const size_t m0 = (size_t)(unit >> 2) * 128;
#pragma unroll 1
        for (int i0_ = 0; i0_ < 16; i0_ += 8) {
            u32x4 raw[8];
#pragma unroll
            for (int i = 0; i < 8; ++i) raw[i] = *(const u32x4*)(ZB + (m0 + 16 * F.wave + i0_ + i) * 1024 + 512 + 8 * lane);
#pragma unroll
            for (int i = 0; i < 8; ++i) { const int sidx = 16 * F.wave + i0_ + i; float f[8]; unpack8(raw[i], f);
                float sum = 0.f;
#pragma unroll
                for (int j = 0; j < 8; ++j) sum += f[j];
                const float mean = wave_sum(sum) * (1.f / 512.f); float q = 0.f;
#pragma unroll
                for (int j = 0; j < 8; ++j) { const float d = f[j] - mean; q += d * d; }
                const float var = wave_sum(q) * (1.f / 512.f);
                if (lane == 0) { st[2 * sidx] = mean; st[2 * sidx + 1] = rsqrtf(var + 1e-5f); } } }
        __syncthreads();
        { u32x4 raw[4];
#pragma unroll
          for (int q4 = 0; q4 < 4; ++q4) { const int it = tid + q4 * NTHREADS; raw[q4] = *(const u32x4*)(ZB + (m0 + (it >> 4)) * 1024 + 512 + g * 128 + 8 * (it & 15)); }
#pragma unroll
          for (int q4 = 0; q4 < 4; ++q4) { const int it = tid + q4 * NTHREADS; const int sidx = it >> 4, c = it & 15; const int ch = g * 128 + 8 * c;
            float f[8]; unpack8(raw[q4], f);
            const float mean = st[2 * sidx], rstd = st[2 * sidx + 1];
            const f32x4 g0 = *(const f32x4*)(lnv_g + ch), g1 = *(const f32x4*)(lnv_g + ch + 4), b0 = *(const f32x4*)(lnv_b + ch), b1 = *(const f32x4*)(lnv_b + ch + 4);
#pragma unroll
            for (int j = 0; j < 8; ++j) { const float gv = j < 4 ? g0[j & 3] : g1[j & 3], bv = j < 4 ? b0[j & 3] : b1[j & 3];
                vt[(8 * c + j) * VT_LD + sidx] = f2bf((f[j] - mean) * rstd * gv + bv); } } }
        __syncthreads();
        const int tile_t = F.wave & 3;
#pragma unroll 1
        for (int dd = 0; dd < 2; ++dd) { const int tile_d = 2 * (F.wave >> 2) + dd;
            f32x16 acc;
#pragma unroll
            for (int r = 0; r < 16; ++r) acc[r] = 0.f;
            const LAS bf16* arow = vt + (32 * tile_d + l31) * VT_LD + 8 * hh; const bf16* brow = WSB + (size_t)(g * 128 + 32 * tile_t + l31) * 128 + 8 * hh;
            for (int ks = 0; ks < 2 * (tile_t + 1); ++ks) acc = __builtin_amdgcn_mfma_f32_32x32x16_bf16(*(const LAS bf16x8*)(arow + 16 * ks), *(const bf16x8*)(brow + 16 * ks), acc, 0, 0, 0);
            const int t = 32 * tile_t + l31; const size_t m = m0 + t; const float bs = b_s[g * 128 + t];
#pragma unroll
            for (int g4 = 0; g4 < 4; ++g4) { const int ch = g * 128 + 32 * tile_d + 8 * g4 + 4 * hh; const u32x2 u2 = *(const u32x2*)(ZB + m * 1024 + ch);
                u32x2 w; w.x = pg8::cvt_pk_bf16(bflo(u2.x) * (acc[4 * g4] + bs), bfhi(u2.x) * (acc[4 * g4 + 1] + bs)); w.y = pg8::cvt_pk_bf16(bflo(u2.y) * (acc[4 * g4 + 2] + bs), bfhi(u2.y) * (acc[4 * g4 + 3] + bs));
                *(u32x2*)(YB + m * AW + ch) = w; }
        }
    }
}

__global__ void __launch_bounds__(NTHREADS, 2) mega(Args args) {
    extern __shared__ __attribute__((aligned(16))) unsigned char lds_raw[];
    Frame F; F.lds = (LAS unsigned char*)lds_raw;
    F.wave = __builtin_amdgcn_readfirstlane((int)(threadIdx.x >> 6));
    F.G = gridDim.x; { const int bx = blockIdx.x; F.vcu = (F.G % 8 == 0) ? (bx % 8) * (F.G / 8) + bx / 8 : bx; }
    unsigned char* ws = args.ws;
    unsigned* ctl = (unsigned*)(ws + WS_CTL);
    for (int u = F_TID; u < (LDS_BYTES - LDSCTL_OFF) / 4; u += NTHREADS) ((LAS unsigned*)(F.lds + LDSCTL_OFF))[u] = 0u;
    __syncthreads();
    XcdBarrier bar = xcd_barrier_post(ctl + CW_BAR + args.li * XCD_BAR_WORDS, (volatile LAS unsigned*)(F.lds + MISC_OFF) + 8);
    const int lo = args.ph_lo, hi = args.ph_hi;
#ifndef ONLY_PH
#define ONLY_PH -1
#endif
#define IN(k) ((ONLY_PH < 0 || ONLY_PH == (k)) && lo <= (k) && (k) < hi)
#define SEAM(k) do { if (IN(k) && IN((k) + 1)) { xcd_barrier(bar); if (REP_PH == 100 + (k)) xcd_barrier(bar); } } while (0)
    bf16* WIN = (bf16*)(ws + WS_WIN); bf16* WOA = (bf16*)(ws + WS_WOA); bf16* WOB = (bf16*)(ws + WS_WOB); bf16* WOUT = (bf16*)(ws + WS_WOUT);
    bf16* H1 = (bf16*)args.out;
    bf16* PA = (bf16*)(ws + WS_PA), *ZB = (bf16*)(ws + WS_ZB), *GT = (bf16*)(ws + WS_GT);

    for (int rep_ = 0; rep_ < (REP_PH == PH_P0 ? 2 : 1); ++rep_) if (IN(PH_P0)) {
        LAS float* scr = (LAS float*)(F.lds + F.wave * 16384);
        const int gw = F.vcu * NWAVES + F.wave, NGW = F.G * NWAVES;
        constexpr int I_IN = 16 * 153, I_OA = 8 * 32, I_OUT = 16 * 32, NITEMS = I_IN + 2 * I_OA + I_OUT;
        for (int it = gw; it < NITEMS; it += NGW) {
            int r = it;
            if (r < I_IN) { const int kb = r / 153, nb = r % 153; p0_transpose_item(args.in[2], 1024, IN_COLS, WIN, 1024, (32 * nb >= A_COLS) ? 224 : 0, scr, kb, nb, F_LANE); continue; } r -= I_IN;
            if (r < I_OA) { p0_transpose_item(args.in[15], 512, 1024, WOA, 512, 0, scr, r / 32, r % 32, F_LANE); continue; } r -= I_OA;
            if (r < I_OA) { p0_transpose_item(args.in[20], 512, 1024, WOB, 512, 0, scr, r / 32, r % 32, F_LANE); continue; } r -= I_OA;
            p0_transpose_item(args.in[21], 1024, 1024, WOUT, 1024, 0, scr, r / 32, r % 32, F_LANE);
        }
        for (int i = gw * 64 + F_LANE; i < 224 * 1024 / 8; i += NGW * 64) ((u32x4*)(WIN + (size_t)A_COLS * 1024))[i] = (u32x4){0u, 0u, 0u, 0u};
        { bf16* W2T = (bf16*)(ws + WS_W2T); bf16* A2T = (bf16*)(ws + WS_A2T); bf16* G2T = (bf16*)(ws + WS_G2T); bf16* WSB = (bf16*)(ws + WS_WSB);
          const int gt = gw * 64 + F_LANE, NT_ = NGW * 64;
          for (int i = gt; i < 512 * 64; i += NT_) { const int n = i >> 6, k = i & 63; W2T[i] = f2bf(args.in[6][k * 512 + n]); A2T[i] = f2bf(args.in[8][k * 512 + n]); }
          for (int i = gt; i < 512 * 160; i += NT_) { const int n = i / 160, k = i - n * 160; G2T[i] = f2bf(args.in[9][k * 512 + n]); }
          { bf16* WRT = (bf16*)(ws + WS_WRT); const float* w_rg = args.in[23]; const float* w_re = args.in[25];
            for (int i = gt; i < 64 * 1024; i += NT_) { const int n = i >> 10, k = i & 1023;
                WRT[i] = n < 32 ? f2bf(w_re[((size_t)(n >> 3) * 1024 + k) * 8 + (n & 7)]) : (n < 36 ? f2bf(w_rg[k * 4 + (n - 32)]) : (bf16)0); } }
          for (int i = gt; i < 4 * 128 * 128; i += NT_) { const int tq = (i >> 7) & 127, sq = i & 127; WSB[i] = sq <= tq ? f2bf(args.in[18][i]) : (bf16)0; } }
        const float* x = args.in[0]; const float* g1 = args.in[1];
        for (int m = gw; m < M; m += NGW) {
            const f32x4* xr = (const f32x4*)(x + (size_t)m * D) + F_LANE;
            f32x4 v[4]; float s = 0.f;
#pragma unroll
            for (int j = 0; j < 4; ++j) { v[j] = xr[64 * j]; s += (v[j].x * v[j].x + v[j].y * v[j].y) + (v[j].z * v[j].z + v[j].w * v[j].w); }
            const float rs = rsqrtf(wave_sum(s) * (1.f / D) + 1e-6f);
            u32x2* o8 = (u32x2*)(H1 + (size_t)m * D) + F_LANE;
#pragma unroll
            for (int j = 0; j < 4; ++j) { const f32x4 gg = *((const f32x4*)g1 + F_LANE + 64 * j);
                u32x2 w; w.x = pk2(v[j].x * rs * gg.x, v[j].y * rs * gg.y); w.y = pk2(v[j].z * rs * gg.z, v[j].w * rs * gg.w); o8[64 * j] = w; }
        }
    }
    SEAM(PH_P0);
    for (int rep_ = 0; rep_ < (REP_PH == PH_GEMM1 ? 2 : 1); ++rep_) if (IN(PH_GEMM1)) {
        pg8::Gemm g{D, D, D}; pg8::StaticOrder S; S.init(H1, WIN, D, D, M, N1, F.G, (int)blockIdx.x);
        Epi1 E{PA, ZB, GT, args.in[3]};
        pg8::gemm_phase<Epi1, pg8::StaticOrder, true, true>(F.lds, g, S, E);
    }
    SEAM(PH_GEMM1);
    for (int rep_ = 0; rep_ < (REP_PH == PH_PREP ? 2 : 1); ++rep_) if (IN(PH_PREP)) {
        PrepBufs PB{PA, args.in[4], args.in[5], args.in[7], args.in[10], args.in[11], (const bf16*)(ws + WS_W2T), (const bf16*)(ws + WS_A2T), (const bf16*)(ws + WS_G2T),
                    (bf16*)args.out, (bf16*)((char*)args.out + 16 * MiB), (bf16*)((char*)args.out + 32 * MiB), (bf16*)((char*)args.out + 48 * MiB), (bf16*)(ws + WS_LW), (bf16*)(ws + WS_VV), (bf16*)(ws + WS_GG)};
#ifndef NO_PREP
        prep_phase(F, PB);
#endif
    }
    SEAM(PH_PREP);
    ScanBufs SB{(const bf16*)args.out, (const bf16*)((char*)args.out + 16 * MiB), (const bf16*)((char*)args.out + 32 * MiB), (const bf16*)((char*)args.out + 48 * MiB),
                (const bf16*)(ws + WS_LW), (const bf16*)(ws + WS_VV), (const bf16*)(ws + WS_GG), (bf16*)(ws + WS_PHIT), (bf16*)(ws + WS_QT), (bf16*)(ws + WS_LT), (bf16*)(ws + WS_YL),
                (bf16*)((char*)args.out + 16 * MiB), (bf16*)(ws + WS_YA)};
#ifndef NO_S1
    for (int rep_ = 0; rep_ < (REP_PH == PH_SCAN1 ? 2 : 1); ++rep_) if (IN(PH_SCAN1)) scan_pass1_h(F, SB);
#endif
    SEAM(PH_SCAN1);
#ifndef NO_S2
    if (IN(PH_SCAN2)) {
        scan_pass2(F, SB);
        gmlp_phase(F, ZB, args.in[16], args.in[17], (const bf16*)(ws + WS_WSB), args.in[19], (bf16*)(ws + WS_YB), ctl + CW_GQ);
    }
#endif
    SEAM(PH_SCAN2);
#ifndef NO_S3
    for (int rep_ = 0; rep_ < (REP_PH == PH_SCAN3 ? 2 : 1); ++rep_) if (IN(PH_SCAN3)) scan_pass3(F, SB, args.in[12], args.in[13], args.in[14]);
#endif
    SEAM(PH_SCAN3);
    bf16* YB = (bf16*)(ws + WS_YB), *YA = (bf16*)(ws + WS_YA), *MIX = (bf16*)(ws + WS_MIX);
    float* X1 = args.out;
    for (int rep_ = 0; rep_ < (REP_PH == PH_MIX ? 2 : 1); ++rep_) if (IN(PH_MIX)) {
        pg8::Gemm g{AW, AW, AW}; MixOrder S{(const char*)YA, (const char*)YB, (const char*)WOA, (const char*)WOB, F.G, (int)blockIdx.x};
        EpiMix E{GT, MIX};
        pg8::gemm_phase<EpiMix, MixOrder, true, true>(F.lds, g, S, E);
    }
    SEAM(PH_MIX);
    for (int rep_ = 0; rep_ < (REP_PH == PH_WOUT ? 2 : 1); ++rep_) if (IN(PH_WOUT)) {
        pg8::Gemm g{D, D, D}; pg8::StaticOrder S; S.init(MIX, WOUT, D, D, M, D, F.G, (int)blockIdx.x);
        EpiX1 E{args.in[0], X1};
        pg8::gemm_phase<EpiX1, pg8::StaticOrder, true, true>(F.lds, g, S, E);
    }
    SEAM(PH_WOUT);
    unsigned* cnt = ctl + CW_CNT;
    bf16* H2 = (bf16*)(ws + WS_H2M); bf16* HG = (bf16*)(ws + WS_HG); bf16* YE = (bf16*)(ws + WS_YE); bf16* ACT = (bf16*)(ws + WS_ACT); bf16* WGU = (bf16*)(ws + WS_WGU); bf16* WD = (bf16*)(ws + WS_WD);
    int2* SEL_E = (int2*)(ws + WS_SELE); float2* SEL_W = (float2*)(ws + WS_SELW); int2* SEL_P = (int2*)(ws + WS_SELP); int2* ROW = (int2*)(ws + WS_ROW);
    if (IN(PH_ROUTER)) {
        volatile LAS int* lcnt = (volatile LAS int*)(F.lds + TAB_OFF + 256);
        const float* g2n = args.in[22]; const float* b_rg = args.in[24]; const float* b_re = args.in[26];
        const bf16* WRT = (const bf16*)(ws + WS_WRT);
        LAS unsigned char* hb = F.lds + F.wave * 16384;
        const int lane = F_LANE, l31 = lane & 31, hh = lane >> 5;
        for (int mb = F.vcu; mb < M / 64; mb += F.G) {
            __syncthreads();
            if (F_TID < 64) lcnt[F_TID] = 0;
            __syncthreads();
#pragma unroll 1
            for (int i0_ = 0; i0_ < 8; i0_ += 4) {
                f32x4 xv[4][4];
#pragma unroll
                for (int i = 0; i < 4; ++i) { const f32x4* xr = (const f32x4*)(X1 + (size_t)(mb * 64 + F.wave * 8 + i0_ + i) * D) + lane;
#pragma unroll
                    for (int j = 0; j < 4; ++j) xv[i][j] = xr[64 * j]; }
#pragma unroll
                for (int i = 0; i < 4; ++i) { const int row = i0_ + i; const size_t m = (size_t)mb * 64 + F.wave * 8 + row; float sq = 0.f;
#pragma unroll
                    for (int j = 0; j < 4; ++j) sq += (xv[i][j].x * xv[i][j].x + xv[i][j].y * xv[i][j].y) + (xv[i][j].z * xv[i][j].z + xv[i][j].w * xv[i][j].w);
                    const float rs = rsqrtf(wave_sum(sq) * (1.f / D) + 1e-6f);
#pragma unroll
                    for (int j = 0; j < 4; ++j) { const f32x4 gg = *((const f32x4*)g2n + lane + 64 * j);
                        u32x2 w; w.x = pg8::cvt_pk_bf16(xv[i][j].x * rs * gg.x, xv[i][j].y * rs * gg.y); w.y = pg8::cvt_pk_bf16(xv[i][j].z * rs * gg.z, xv[i][j].w * rs * gg.w);
                        ((u32x2*)(H2 + m * D))[lane + 64 * j] = w;
                        *(LAS u32x2*)(hb + row * 2048 + ((((lane >> 1) + 32 * j) ^ row) << 4) + ((lane & 1) << 3)) = w; } }
            }
            asm volatile("s_waitcnt lgkmcnt(0)" ::: "memory");
            f32x16 acc[2];
#pragma unroll
            for (int ct = 0; ct < 2; ++ct)
#pragma unroll
                for (int r = 0; r < 16; ++r) acc[ct][r] = 0.f;
            const int arow = l31 & 7;
            const bf16* wrow = WRT + (size_t)l31 * 1024 + 8 * hh;
#pragma unroll 4
            for (int ks = 0; ks < 64; ++ks) { const bf16x8 af = *(const LAS bf16x8*)(hb + arow * 2048 + (((2 * ks + hh) ^ arow) << 4));
                acc[0] = __builtin_amdgcn_mfma_f32_32x32x16_bf16(af, *(const bf16x8*)(wrow + 16 * ks), acc[0], 0, 0, 0);
                acc[1] = __builtin_amdgcn_mfma_f32_32x32x16_bf16(af, *(const bf16x8*)(wrow + 32 * 1024 + 16 * ks), acc[1], 0, 0, 0); }
            asm volatile("s_waitcnt lgkmcnt(0)" ::: "memory");
            LAS float* lg = (LAS float*)hb;
#pragma unroll
            for (int r = 0; r < 4; ++r) { lg[(r + 4 * hh) * 64 + l31] = acc[0][r]; lg[(r + 4 * hh) * 64 + 32 + l31] = acc[1][r]; }
            asm volatile("s_waitcnt lgkmcnt(0)" ::: "memory");
            if (lane < 8) { const int tl = F.wave * 8 + lane; const size_t m = (size_t)mb * 64 + tl; const LAS float* lp = lg + lane * 64;
                float gl[4];
#pragma unroll
                for (int gi = 0; gi < 4; ++gi) gl[gi] = lp[32 + gi] + b_rg[gi];
                int gs = 0; float gm = gl[0];
#pragma unroll
                for (int gi = 1; gi < 4; ++gi) if (gl[gi] > gm) { gm = gl[gi]; gs = gi; }
                float den = 0.f;
#pragma unroll
                for (int gi = 0; gi < 4; ++gi) den += expf(gl[gi] - gm);
                const float gp = 1.f / den;
                float el[8];
#pragma unroll
                for (int e = 0; e < 8; ++e) el[e] = lp[gs * 8 + e] + b_re[gs * 8 + e];
                int i1 = 0; float m1 = el[0];
#pragma unroll
                for (int e = 1; e < 8; ++e) if (el[e] > m1) { m1 = el[e]; i1 = e; }
                int i2 = -1; float m2 = -INFINITY;
#pragma unroll
                for (int e = 0; e < 8; ++e) if (e != i1 && el[e] > m2) { m2 = el[e]; i2 = e; }
                const float w1 = 1.f / (1.f + expf(m2 - m1)), w2 = 1.f - w1;
                const int e1 = gs * 8 + i1, e2 = gs * 8 + i2;
                SEL_E[m] = make_int2(e1, e2); SEL_W[m] = make_float2(w1 * gp, w2 * gp);
                lcnt[64 + 2 * tl] = __hip_atomic_fetch_add((LAS int*)&lcnt[e1], 1, __ATOMIC_RELAXED, __HIP_MEMORY_SCOPE_WORKGROUP);
                lcnt[64 + 2 * tl + 1] = __hip_atomic_fetch_add((LAS int*)&lcnt[e2], 1, __ATOMIC_RELAXED, __HIP_MEMORY_SCOPE_WORKGROUP);
                lcnt[192 + 2 * tl] = e1; lcnt[192 + 2 * tl + 1] = e2; }
            __syncthreads();
            if (F_TID < 32) lcnt[32 + F_TID] = (int)__hip_atomic_fetch_add(cnt + F_TID, (unsigned)lcnt[F_TID], __ATOMIC_RELAXED, __HIP_MEMORY_SCOPE_AGENT);
            __syncthreads();
            if (F_TID < 64) { const int m = mb * 64 + F_TID; const int e1 = lcnt[192 + 2 * F_TID], e2 = lcnt[192 + 2 * F_TID + 1];
                SEL_P[m] = make_int2(lcnt[32 + e1] + lcnt[64 + 2 * F_TID], lcnt[32 + e2] + lcnt[64 + 2 * F_TID + 1]); }
        }
        __syncthreads();
        LAS float* scr = (LAS float*)(F.lds + 4096 + F.wave * 12288);
        const int gw = F.vcu * NWAVES + F.wave, NGW = F.G * NWAVES;
        for (int rep2_ = 0; rep2_ < (REP_PH == 50 ? 2 : 1); ++rep2_)
        for (int it = gw; it < 3 * 4096; it += NGW) { const int which = it >> 12, r = it & 4095;
            if (which < 2) { const int e = r >> 7, kb = (r >> 3) & 15, nb = r & 7;
                p0_transpose_item(args.in[27 + which] + (size_t)e * 1024 * 256, 1024, 256, WGU + (size_t)e * 512 * 1024, 1024, ((32 * nb) >> 7) * 128 + which * 128, scr, kb, nb, F_LANE); }
            else { const int e = r >> 7, kb = (r >> 5) & 3, nb = r & 31;
                p0_transpose_item(args.in[29] + (size_t)e * 256 * 1024, 256, 1024, WD + (size_t)e * 1024 * 256, 256, 0, scr, kb, nb, F_LANE); } }
    }
    SEAM(PH_ROUTER);
    for (int rep_ = 0; rep_ < (REP_PH == PH_GATHER ? 2 : 1); ++rep_) if (IN(PH_GATHER)) {
        moe_tables(F, cnt);
        LAS const int* tab = (LAS const int*)(F.lds + TAB_OFF);
        const int gw = F.vcu * NWAVES + F.wave, NGW = F.G * NWAVES;
        for (int m = gw; m < M; m += NGW) { const int2 se = SEL_E[m]; const int2 sp = SEL_P[m];
            const int r1 = tab[se.x] * 256 + sp.x, r2 = tab[se.y] * 256 + sp.y;
            const u32x4* src = (const u32x4*)(H2 + (size_t)m * D); const u32x4 a = src[F_LANE], b = src[F_LANE + 64];
            u32x4* d1 = (u32x4*)(HG + (size_t)r1 * D); u32x4* d2 = (u32x4*)(HG + (size_t)r2 * D);
            d1[F_LANE] = a; d1[F_LANE + 64] = b; d2[F_LANE] = a; d2[F_LANE + 64] = b;
            if (F_LANE == 0) ROW[m] = make_int2(r1, r2); }
    }
    SEAM(PH_GATHER);
    for (int rep_ = 0; rep_ < (REP_PH == PH_MOE1 ? 2 : 1); ++rep_) if (IN(PH_MOE1)) {
        moe_tables(F, cnt);
        LAS const int* tab = (LAS const int*)(F.lds + TAB_OFF);
        pg8::Gemm g{D, D, D}; MoeOrder S{(const char*)HG, (const char*)WGU, tab, tab[32], 2, F.G, (int)blockIdx.x, (size_t)256 * 1024 * 2, (size_t)512 * 1024 * 2, (size_t)256 * 1024 * 2};
        EpiAct E{ACT};
        pg8::gemm_phase<EpiAct, MoeOrder, true, true>(F.lds, g, S, E);
    }
    SEAM(PH_MOE1);
    for (int rep_ = 0; rep_ < (REP_PH == PH_MOE2 ? 2 : 1); ++rep_) if (IN(PH_MOE2)) {
        moe_tables(F, cnt);
        LAS const int* tab = (LAS const int*)(F.lds + TAB_OFF);
        pg8::Gemm g{256, 256, 256}; MoeOrder S{(const char*)ACT, (const char*)WD, tab, tab[32], 4, F.G, (int)blockIdx.x, (size_t)256 * 256 * 2, (size_t)1024 * 256 * 2, (size_t)256 * 256 * 2};
        EpiYE E{YE};
        pg8::gemm_phase<EpiYE, MoeOrder, true, true>(F.lds, g, S, E);
    }
    SEAM(PH_MOE2);
    if (IN(PH_FINAL)) {
        const int gw = F.vcu * NWAVES + F.wave, NGW = F.G * NWAVES; const float* fg = args.in[30];
        for (int rr_ = 0; rr_ < (REP_PH == 52 ? 2 : 1); ++rr_) { const bool live = (REP_PH != 52) || rr_ == 1 || __hip_atomic_load(ctl + 700, __ATOMIC_RELAXED, __HIP_MEMORY_SCOPE_AGENT) == 12345u;
        for (int m = gw; m < M; m += NGW) { const int2 rw = ROW[m]; const float2 sw = SEL_W[m];
            const f32x4* xr = (const f32x4*)(X1 + (size_t)m * D) + F_LANE; const u32x2* y1 = (const u32x2*)(YE + (size_t)rw.x * D) + F_LANE; const u32x2* y2 = (const u32x2*)(YE + (size_t)rw.y * D) + F_LANE;
            f32x4 v[4]; float sq = 0.f;
#pragma unroll
            for (int j = 0; j < 4; ++j) { const f32x4 xv = xr[64 * j]; const u32x2 a = y1[64 * j], b = y2[64 * j];
                v[j].x = xv.x + sw.x * __uint_as_float(a.x << 16) + sw.y * __uint_as_float(b.x << 16);
                v[j].y = xv.y + sw.x * __uint_as_float(a.x & 0xffff0000u) + sw.y * __uint_as_float(b.x & 0xffff0000u);
                v[j].z = xv.z + sw.x * __uint_as_float(a.y << 16) + sw.y * __uint_as_float(b.y << 16);
                v[j].w = xv.w + sw.x * __uint_as_float(a.y & 0xffff0000u) + sw.y * __uint_as_float(b.y & 0xffff0000u);
                sq += (v[j].x * v[j].x + v[j].y * v[j].y) + (v[j].z * v[j].z + v[j].w * v[j].w); }
            const float rs = rsqrtf(wave_sum(sq) * (1.f / D) + 1e-6f);
            f32x4* o = (f32x4*)(args.out + (size_t)m * D) + F_LANE;
#pragma unroll
            for (int j = 0; j < 4; ++j) { const f32x4 gg = *((const f32x4*)fg + F_LANE + 64 * j); if (live) o[64 * j] = (f32x4){v[j].x * rs * gg.x, v[j].y * rs * gg.y, v[j].z * rs * gg.z, v[j].w * rs * gg.w}; }
        }
        }
    }
#undef IN
#undef SEAM
}
}

extern "C" void kernel_launch(void* const* d_in, const int* in_sizes, int n_in, void* d_out, int out_size, void* d_ws, size_t ws_size, hipStream_t stream) {
    char* ws = (char*)d_ws;
    static int grid = 0;
    if (grid == 0) {
        int dev = 0, cus = 0;
        if (hipGetDevice(&dev) != hipSuccess || hipDeviceGetAttribute(&cus, hipDeviceAttributeMultiprocessorCount, dev) != hipSuccess) { grid = -1; return; }
        if (hipFuncSetAttribute((const void*)mega, hipFuncAttributeMaxDynamicSharedMemorySize, LDS_BYTES) != hipSuccess) { grid = -1; return; }
        grid = cus;
    }
    if (grid < 0) return;
    (void)hipMemsetAsync(ws + WS_CTL, 0, CTL_ZERO_BYTES, stream);
    Args a{};
    for (int i = 0; i < 31; ++i) a.in[i] = (const float*)d_in[i];
    a.out = (float*)d_out; a.ws = (unsigned char*)d_ws;
    auto launch = [&](int lo, int hi, int li) { a.ph_lo = lo; a.ph_hi = hi; a.li = li; hipLaunchKernelGGL(mega, dim3(grid), dim3(NTHREADS), LDS_BYTES, stream, a); };
    launch(PH_P0, PH_END, 0);
}
```

```cpp
#ifndef REP_PH
#define REP_PH -1
#endif
#include <hip/hip_runtime.h>
#include <stdint.h>
#include <math.h>

namespace {
typedef unsigned short bf16;
constexpr int D = 1024, BATCH = 8, T = 2048, M = BATCH * T;
constexpr int AW = 512;
constexpr int A_COLS = 1824, B_COLS = 1024, IN_COLS = 4896;
constexpr int PA_LD = 2048;
constexpr size_t MiB = 1u << 20;
constexpr size_t WS_PA = 16 * MiB, WS_ZB = 80 * MiB, WS_GT = 112 * MiB, WS_LW = 176 * MiB, WS_VV = 192 * MiB, WS_GG = 208 * MiB,
                 WS_YB = 224 * MiB, WS_YA = 240 * MiB, WS_Y = 16 * MiB  , WS_MIX = 48 * MiB, WS_H2 = 80 * MiB, WS_SEL = 15 * MiB;

__device__ __forceinline__ float bf2f(bf16 b) { return __uint_as_float(((unsigned)b) << 16); }
__device__ __forceinline__ bf16 f2bf(float f) { unsigned u = __float_as_uint(f); u += 0x7fffu + ((u >> 16) & 1u); return (bf16)(u >> 16); }
__device__ __forceinline__ float wave_sum(float v) {
#pragma unroll
    for (int o = 1; o < 64; o <<= 1) v += __shfl_xor(v, o);
    return v;
}
__device__ __forceinline__ float sigmoidf_(float x) { return 1.f / (1.f + expf(-x)); }

#define LAS __attribute__((address_space(3)))
#define GAS __attribute__((address_space(1)))
typedef short bf16x8 __attribute__((ext_vector_type(8)));
typedef float f32x4 __attribute__((ext_vector_type(4)));
typedef float f32x2 __attribute__((ext_vector_type(2)));
typedef unsigned u32x4 __attribute__((ext_vector_type(4)));
typedef unsigned u32x2 __attribute__((ext_vector_type(2)));

namespace pg8 {
constexpr int BM = 256, BK = 64, HALF = 128, HTB = HALF * BK * 2, STAGE_BYTES = 8 * HTB, NXCD = 8, WGM = 8;
__device__ __forceinline__ int lds_byte(int r, int c) { const int st = (r >> 4) * 2 + (c >> 5), rr = r & 15, cc = c & 31, ob = rr * 64 + cc * 2; return st * 1024 + (ob ^ (((ob >> 9) & 1) << 5)); }
__device__ __forceinline__ void stage_rc(int b, int& R, int& C) { const int st = b / 1024, sb = b % 1024, swz = sb ^ (((sb >> 9) & 1) << 5); R = (st >> 1) * 16 + swz / 64; C = (st & 1) * 32 + (swz % 64) / 2; }
__device__ __forceinline__ int perm32(int rho) { const int n = rho >> 4, i = rho & 15; return 8 * (i >> 2) + 4 * n + (i & 3); }

struct Unit { int pm, pn; const char* A; const char* B; int aux; int rt; };
struct Gemm { int lda, ldb, K; };

__device__ __forceinline__ void tile_order(int L, int nM, int nN, int& pm, int& pn) {
    const int nwg = nM * nN; int wgid = L; { const int q = nwg / NXCD, r = nwg % NXCD, xcd = wgid % NXCD, off = wgid / NXCD; wgid = (xcd < r ? xcd * (q + 1) : r * (q + 1) + (xcd - r) * q) + off; }
    const int nig = WGM * nN, gid = wgid / nig, fm = gid * WGM, gsz = (nM - fm) < WGM ? (nM - fm) : WGM;
    pm = fm + ((wgid % nig) % gsz); pn = (wgid % nig) / gsz;
}
struct StaticOrder {
    const char* A; const char* B; int lda, ldb, nM, nN, nwg, G, c;
    __device__ void init(const void* A_, const void* B_, int lda_, int ldb_, int M, int N, int G_, int c_) { A = (const char*)A_; B = (const char*)B_; lda = lda_; ldb = ldb_; nM = M / BM; nN = N / BM; nwg = nM * nN; G = G_; c = c_; }
    __device__ __forceinline__ bool next(int i, Unit& u) const {
        const int L = i * G + c; if (L >= nwg) return false;
        tile_order(L, nM, nN, u.pm, u.pn);
        u.A = A + (size_t)u.pm * BM * lda * 2; u.B = B + (size_t)u.pn * BM * ldb * 2; u.aux = 0; u.rt = 0; return true;
    }
};

typedef __bf16 bf16x2_t __attribute__((ext_vector_type(2)));
__device__ __forceinline__ unsigned cvt_pk_bf16(float lo, float hi) { f32x2 v = {lo, hi}; bf16x2_t b = __builtin_convertvector(v, bf16x2_t); return __builtin_bit_cast(unsigned, b); }
__device__ __forceinline__ f32x2 gelu_pk(f32x2 v) {
    const f32x2 av = __builtin_elementwise_abs(v), d = av * 0.2316418882f + 1.0f;
    f32x2 t; t.x = __builtin_amdgcn_rcpf(d.x); t.y = __builtin_amdgcn_rcpf(d.y);
    f32x2 q = t * 0.5307027145f + (-0.7265760135f); q = q * t + 0.7107068705f; q = q * t + (-0.142248368f); q = q * t + 0.127414796f; q = q * t;
    const f32x2 s = (v * v) * (-0.72134752044f);
    f32x2 e; e.x = __builtin_amdgcn_exp2f(s.x); e.y = __builtin_amdgcn_exp2f(s.y);
    const f32x2 m = v * (q * e), r = v - m;
    f32x2 o; o.x = v.x < 0.f ? m.x : r.x; o.y = v.y < 0.f ? m.y : r.y; return o;
}
__device__ __forceinline__ float fast_sigmoid(float x) { return __builtin_amdgcn_rcpf(1.0f + __builtin_amdgcn_exp2f(-1.4426950408889634f * x)); }

template <class Epi, class Sched, bool ALIGN_EPI, bool GATHER = false>
__device__ __forceinline__ void gemm_phase(LAS unsigned char* lds, const Gemm g, const Sched& S, const Epi& E) {
    int tid_ = threadIdx.x; asm volatile("" : "+v"(tid_));
    const int tid = tid_, wid = __builtin_amdgcn_readfirstlane(tid >> 6), lane = tid & 63, wr = wid >> 2, wc = wid & 3, fr = lane & 15, fq = lane >> 4;
    const int K = g.K, nt = K / BK;
    unsigned voffA[2], voffB[2];
#pragma unroll
    for (int i = 0; i < 2; ++i) { int R, C; stage_rc(tid * 16 + i * 8192, R, C); const int Rb = Epi::PERM ? ((R & ~31) + perm32(R & 31)) : R;
        voffA[i] = (unsigned)(R * g.lda + C) * 2u; voffB[i] = (unsigned)(Rb * g.ldb + C) * 2u; }
    const size_t kstep = (size_t)(BK * 2);
    const size_t hstepA = GATHER ? (size_t)0 : (size_t)HALF * g.lda * 2, hstepB = (size_t)HALF * g.ldb * 2;
    const unsigned ldsw = (unsigned)wid * 1024u;
    const int aoff = lds_byte(wr * 64 + fr, fq * 8), boff = lds_byte(wc * 32 + fr, fq * 8);
    unsigned gc[2][2], gn[2][2];
#define PG8_LOADG(u_, o_) do { _Pragma("unroll") for (int _i = 0; _i < 2; ++_i) { int R_, C_; stage_rc(tid * 16 + _i * 8192, R_, C_); \
        _Pragma("unroll") for (int _h = 0; _h < 2; ++_h) o_[_h][_i] = *(const LAS unsigned*)(lds + (u_).rt + (R_ + HALF * _h) * 4) + (unsigned)C_ * 2u; } } while (0)
#define PG8_SA(b, h) (((b) * 2 + (h)) * HTB)
#define PG8_SB(b, h) ((4 + (b) * 2 + (h)) * HTB)
#define PG8_STAGE(bufoff, gbase, voff) do { _Pragma("unroll") for (int _i = 0; _i < 2; ++_i) \
        __builtin_amdgcn_global_load_lds((const unsigned*)((const char*)(gbase) + (voff)[_i]), (LAS unsigned*)(lds + (bufoff) + ldsw + _i * 8192), 16, 0, 0); } while (0)
#define PG8_STAGE_A(bufoff, kptr, h, nx) do { if constexpr (GATHER) { _Pragma("unroll") for (int _i = 0; _i < 2; ++_i) { const unsigned _o = (nx) ? gn[h][_i] : gc[h][_i]; \
        __builtin_amdgcn_global_load_lds((const unsigned*)((const char*)(kptr) + _o), (LAS unsigned*)(lds + (bufoff) + ldsw + _i * 8192), 16, 0, 0); } } \
        else PG8_STAGE(bufoff, (const char*)(kptr) + (h) * hstepA, voffA); } while (0)
#define PG8_LDA(dst, b, h) do { _Pragma("unroll") for (int m = 0; m < 4; ++m) _Pragma("unroll") for (int k = 0; k < 2; ++k) dst[m][k] = *(const LAS bf16x8*)(lds + PG8_SA(b, h) + aoff + m * 2048 + k * 1024); } while (0)
#define PG8_LDB(dst, b, h) do { _Pragma("unroll") for (int n = 0; n < 2; ++n) _Pragma("unroll") for (int k = 0; k < 2; ++k) dst[n][k] = *(const LAS bf16x8*)(lds + PG8_SB(b, h) + boff + n * 2048 + k * 1024); } while (0)
#define PG8_MMA(ai, bj, At, Bt) do { __builtin_amdgcn_s_setprio(1); _Pragma("unroll") for (int m = 0; m < 4; ++m) _Pragma("unroll") for (int n = 0; n < 2; ++n) _Pragma("unroll") for (int k = 0; k < 2; ++k) \
        acc[ai][bj][m][n] = __builtin_amdgcn_mfma_f32_16x16x32_bf16(Bt[n][k], At[m][k], acc[ai][bj][m][n], 0, 0, 0); __builtin_amdgcn_s_setprio(0); } while (0)
#define PG8_WAIT_V(n) asm volatile("s_waitcnt vmcnt(" #n ")" ::: "memory")
#define PG8_WAIT_L(n) asm volatile("s_waitcnt lgkmcnt(" #n ")" ::: "memory")
#define PG8_BAR __builtin_amdgcn_s_barrier()
#define PG8_SCHED __builtin_amdgcn_sched_barrier(0)
    Unit cur, nxt; int ui = 0;
    if (!S.next(0, cur)) return;
    f32x4 acc[2][2][4][2];
#pragma unroll
    for (int a = 0; a < 2; ++a)
#pragma unroll
        for (int b = 0; b < 2; ++b)
#pragma unroll
            for (int m = 0; m < 4; ++m)
#pragma unroll
                for (int n = 0; n < 2; ++n) acc[a][b][m][n] = (f32x4){0.f, 0.f, 0.f, 0.f};
    bf16x8 At[4][2], B0[2][2], B1[2][2];
    const char* cA = cur.A; const char* cB = cur.B;
    if constexpr (GATHER) { PG8_LOADG(cur, gc); PG8_LOADG(cur, gn); }
    PG8_STAGE(PG8_SB(0, 0), cB, voffB); PG8_STAGE(PG8_SB(0, 1), cB + hstepB, voffB); PG8_STAGE_A(PG8_SA(0, 0), cA, 0, false); PG8_STAGE_A(PG8_SA(0, 1), cA, 1, false);
    if (wr == 1) PG8_BAR;
    PG8_WAIT_V(2); PG8_BAR;
    PG8_STAGE(PG8_SB(1, 0), cB + kstep, voffB); PG8_STAGE_A(PG8_SA(1, 0), cA + kstep, 0, false); PG8_STAGE(PG8_SB(1, 1), cB + hstepB + kstep, voffB);
    PG8_WAIT_V(6); PG8_BAR;
    for (;;) {
        const bool has_next = S.next(ui + 1, nxt);
        const char* nA = has_next ? nxt.A : cA; const char* nB = has_next ? nxt.B : cB;
        if constexpr (GATHER) { if (has_next) PG8_LOADG(nxt, gn); else {
#pragma unroll
            for (int _h = 0; _h < 2; ++_h)
#pragma unroll
                for (int _i = 0; _i < 2; ++_i) gn[_h][_i] = gc[_h][_i]; } }
#pragma unroll 1
        for (int t = 0; t < nt; t += 2) {
            const bool last = (t == nt - 2);
            const char* a1 = cA + (size_t)(t + 1) * kstep;
            const char* a2 = last ? nA : cA + (size_t)(t + 2) * kstep; const char* b2 = last ? nB : cB + (size_t)(t + 2) * kstep;
            const char* a3 = a2 + kstep; const char* b3 = b2 + kstep;
            PG8_LDB(B0, 0, 0); PG8_LDB(B1, 0, 1); PG8_SCHED; PG8_LDA(At, 0, 0); PG8_STAGE_A(PG8_SA(1, 1), a1, 1, false);
            PG8_WAIT_V(8); PG8_WAIT_L(0); PG8_BAR; PG8_MMA(0, 0, At, B0); PG8_MMA(0, 1, At, B1); PG8_BAR; PG8_SCHED;
            PG8_LDA(At, 0, 1); PG8_STAGE(PG8_SB(0, 0), b2, voffB); PG8_STAGE(PG8_SB(0, 1), b2 + hstepB, voffB); PG8_STAGE_A(PG8_SA(0, 0), a2, 0, last);
            PG8_WAIT_V(8); PG8_WAIT_L(0); PG8_BAR; PG8_MMA(1, 0, At, B0); PG8_MMA(1, 1, At, B1); PG8_BAR; PG8_SCHED;
            PG8_LDB(B0, 1, 0); PG8_LDB(B1, 1, 1); PG8_SCHED; PG8_LDA(At, 1, 0); PG8_STAGE_A(PG8_SA(0, 1), a2, 1, last);
            PG8_WAIT_V(8); PG8_WAIT_L(0); PG8_BAR; PG8_MMA(0, 0, At, B0); PG8_MMA(0, 1, At, B1); PG8_BAR; PG8_SCHED;
            PG8_LDA(At, 1, 1); PG8_STAGE(PG8_SB(1, 0), b3, voffB); PG8_STAGE(PG8_SB(1, 1), b3 + hstepB, voffB); PG8_STAGE_A(PG8_SA(1, 0), a3, 0, last);
            PG8_WAIT_V(8); PG8_WAIT_L(0); PG8_BAR; PG8_MMA(1, 0, At, B0); PG8_MMA(1, 1, At, B1); PG8_BAR; PG8_SCHED;
        }
        if constexpr (ALIGN_EPI) { if (wr == 0) PG8_BAR; }
        int l2 = lane; asm volatile("" : "+v"(l2));
        const bool keep = E(acc, cur, wr, wc, l2 & 15, l2 >> 4);
        if (!has_next) break;
        if (!keep) {
#pragma unroll
        for (int a = 0; a < 2; ++a)
#pragma unroll
            for (int b = 0; b < 2; ++b)
#pragma unroll
                for (int m = 0; m < 4; ++m)
#pragma unroll
                    for (int n = 0; n < 2; ++n) acc[a][b][m][n] = (f32x4){0.f, 0.f, 0.f, 0.f};
        }
        cur = nxt; cA = nA; cB = nB; ++ui;
        if constexpr (GATHER) {
#pragma unroll
            for (int _h = 0; _h < 2; ++_h)
#pragma unroll
                for (int _i = 0; _i < 2; ++_i) gc[_h][_i] = gn[_h][_i]; }
        if constexpr (ALIGN_EPI) { if (wr == 1) PG8_BAR; }
    }
    PG8_WAIT_V(0);
    if constexpr (!ALIGN_EPI) { if (wr == 0) PG8_BAR; }
    PG8_BAR;
#undef PG8_LOADG
#undef PG8_SA
#undef PG8_SB
#undef PG8_STAGE
#undef PG8_STAGE_A
#undef PG8_LDA
#undef PG8_LDB
#undef PG8_MMA
#undef PG8_WAIT_V
#undef PG8_WAIT_L
#undef PG8_BAR
#undef PG8_SCHED
}
}

#define XB_TMO      128
#define XB_XCNT(j)  (256  + 64 * (j))
#define XB_XSUB(j)  (1280 + 64 * (j))
#define XB_XGEN(j)  (2304 + 64 * (j))
#define XB_TOP      3328
#define XB_TOPGEN   3392
#define XCD_BAR_WORDS 3456
#define XB_SPIN_CAP (1u << 20)
__device__ __forceinline__ unsigned xb_ld(unsigned* p)              { return __hip_atomic_load(p, __ATOMIC_RELAXED, __HIP_MEMORY_SCOPE_AGENT); }
__device__ __forceinline__ unsigned xb_add(unsigned* p, unsigned v) { return __hip_atomic_fetch_add(p, v, __ATOMIC_RELAXED, __HIP_MEMORY_SCOPE_AGENT); }
__device__ __forceinline__ unsigned xb_xcc_id() { return (unsigned)__builtin_amdgcn_s_getreg((3 << 11) | 20) & 0xFu; }
#define XB_SPIN(cond, bar) do { unsigned _sp = 0; while (cond) { __builtin_amdgcn_s_sleep(1); \
    if ((++_sp & 255u) == 0u) { if (xb_ld(&(bar)[XB_TMO])) break; if (_sp > XB_SPIN_CAP) { atomicAdd(&(bar)[XB_TMO], 1u); break; } } } } while (0)
struct XcdBarrier { unsigned* bar; unsigned x; volatile LAS unsigned* st; };
__device__ __forceinline__ XcdBarrier xcd_barrier_post(unsigned* bar, volatile LAS unsigned* st) {
    XcdBarrier b; b.bar = bar; b.x = xb_xcc_id(); b.st = st;
    if (threadIdx.x == 0) (void)xb_add(&bar[XB_XCNT(b.x)], 1u);
    return b;
}
__device__ __forceinline__ void xcd_barrier_complete(unsigned* bar, unsigned x, unsigned& nloc, unsigned& nx) {
    const unsigned G = gridDim.x * gridDim.y * gridDim.z;
    unsigned sum, cnt, mine, sp = 0u;
    for (;;) {
        sum = 0u; cnt = 0u; mine = 0u;
#pragma unroll
        for (unsigned j = 0; j < 16; ++j) { const unsigned c = xb_ld(&bar[XB_XCNT(j)]); sum += c; cnt += (c > 0u) ? 1u : 0u; mine = (j == x) ? c : mine; }
        if (sum == G) break;
        __builtin_amdgcn_s_sleep(1);
        if ((++sp & 255u) == 0u) { if (xb_ld(&bar[XB_TMO])) break; if (sp > XB_SPIN_CAP) { atomicAdd(&bar[XB_TMO], 1u); break; } }
    }
    nloc = mine > 0u ? mine : 1u; nx = cnt > 0u ? cnt : 1u;
}
__device__ __forceinline__ void xcd_barrier(const XcdBarrier& b) {
    asm volatile("s_waitcnt vmcnt(0)" ::: "memory");
    __syncthreads();
    if (threadIdx.x == 0) {
        unsigned* bar = b.bar;
        __builtin_amdgcn_s_waitcnt(0);
        unsigned nloc = b.st[0], nx = b.st[1];
        if (nloc == 0u) { xcd_barrier_complete(bar, b.x, nloc, nx); b.st[0] = nloc; b.st[1] = nx; }
        const unsigned old = xb_add(&bar[XB_XSUB(b.x)], 1u);
        const unsigned gen = old / nloc;
        if (old + 1u == (gen + 1u) * nloc) {
            __builtin_amdgcn_fence(__ATOMIC_RELEASE, "agent");
            asm volatile("s_waitcnt vmcnt(0)" ::: "memory");
            const unsigned og = xb_add(&bar[XB_TOP], 1u);
            const unsigned tg = og / nx;
            if (og + 1u == (tg + 1u) * nx) xb_add(&bar[XB_TOPGEN], 1u);
            else XB_SPIN(xb_ld(&bar[XB_TOPGEN]) == tg, bar);
            __builtin_amdgcn_fence(__ATOMIC_ACQUIRE, "agent");
            xb_add(&bar[XB_XGEN(b.x)], 1u);
            asm volatile("s_waitcnt vmcnt(0)" ::: "memory");
        } else {
            XB_SPIN(xb_ld(&bar[XB_XGEN(b.x)]) == gen, bar);
            __builtin_amdgcn_fence(__ATOMIC_ACQUIRE, "agent");
            asm volatile("s_waitcnt vmcnt(0)" ::: "memory");
        }
    }
    __syncthreads();
}

__device__ __forceinline__ void st_wt8(void* p, unsigned lo, unsigned hi) { __hip_atomic_store((unsigned long long*)p, ((unsigned long long)hi << 32) | lo, __ATOMIC_RELAXED, __HIP_MEMORY_SCOPE_AGENT); }
__device__ __forceinline__ void group_sync(unsigned* ctr, unsigned target, unsigned* tmo) {
    asm volatile("s_waitcnt vmcnt(0)" ::: "memory");
    __syncthreads();
    if (threadIdx.x == 0) {
        (void)xb_add(ctr, 1u);
        unsigned sp = 0u;
        while (xb_ld(ctr) < target) { __builtin_amdgcn_s_sleep(1); if ((++sp & 255u) == 0u) { if (xb_ld(tmo)) break; if (sp > XB_SPIN_CAP) { atomicAdd(tmo, 1u); break; } } }
        __builtin_amdgcn_fence(__ATOMIC_ACQUIRE, "agent");
        asm volatile("s_waitcnt vmcnt(0)" ::: "memory");
    }
    __syncthreads();
}

constexpr int NWAVES = 8, NTHREADS = 512;
constexpr int RING_BYTES = 131072, LDSCTL_OFF = RING_BYTES, MISC_OFF = LDSCTL_OFF + 320, LDS_BYTES = 147456;
constexpr int N1 = 5120;
constexpr size_t WS_CTL = 0, CTL_ZERO_BYTES = 256 * 1024;
constexpr int CW_BAR = 1024;
constexpr size_t WS_WIN = 1 * MiB  , WS_WOA = 11 * MiB, WS_WOB = 12 * MiB, WS_WOUT = 13 * MiB  ;
#define LDS_WAIT() asm volatile("s_waitcnt lgkmcnt(0)" ::: "memory")
constexpr size_t WS_LIST = 192 * MiB;
constexpr int RT_OFF = LDSCTL_OFF + 4096;
constexpr size_t WS_X1 = 80 * MiB;
constexpr size_t WS_YE = 112 * MiB, WS_ACT = 16 * MiB, WS_H2M = 224 * MiB;
constexpr size_t WS_SELE = 15 * MiB, WS_SELW = WS_SELE + 128 * 1024, WS_SELP = WS_SELW + 128 * 1024, WS_ROW = WS_SELP + 128 * 1024;
constexpr int CW_GRP = 8192;
constexpr int CW_GQ = 448;
constexpr int CW_CNT = 512;
constexpr int TAB_OFF = LDSCTL_OFF + 1024;

enum { PH_P0 = 0, PH_GEMM1, PH_PREP, PH_SCAN1, PH_SCAN2, PH_SCAN3, PH_MIX, PH_WOUT, PH_ROUTER, PH_MOE1, PH_MOE2, PH_FINAL, PH_END };
struct Args { const float* in[31]; float* out; unsigned char* ws; int ph_lo, ph_hi, li, pad; };

struct Frame { LAS unsigned char* lds; int wave, vcu, G; };
__device__ __forceinline__ int opaque_tid() { int t = threadIdx.x; asm volatile("" : "+v"(t)); return t; }
#define F_LANE (opaque_tid() & 63)
#define F_TID (opaque_tid())

__device__ __forceinline__ unsigned pk2(float lo, float hi) { return (unsigned)f2bf(lo) | ((unsigned)f2bf(hi) << 16); }
__device__ __forceinline__ void p0_transpose_item(const float* __restrict__ W, int K, int N, bf16* WT, int ldt, int row_off, LAS float* scr, int kb, int nb, int lane) {
    const int k0 = 64 * kb, n0 = 32 * nb;
#pragma unroll 8
    for (int i = 0; i < 32; ++i) { const int kk = 2 * i + (lane >> 5); scr[kk * 33 + (lane & 31)] = W[(size_t)(k0 + kk) * N + n0 + (lane & 31)]; }
    LDS_WAIT(); asm volatile("" ::: "memory");
    const int c = lane & 7;
#pragma unroll
    for (int j = 0; j < 4; ++j) { const int n = (lane >> 3) + 8 * j; const LAS float* s = scr + (8 * c) * 33 + n;
        u32x4 o; o.x = pk2(s[0 * 33], s[1 * 33]); o.y = pk2(s[2 * 33], s[3 * 33]); o.z = pk2(s[4 * 33], s[5 * 33]); o.w = pk2(s[6 * 33], s[7 * 33]);
        *(u32x4*)(WT + (size_t)(row_off + n0 + n) * ldt + k0 + 8 * c) = o; }
    LDS_WAIT(); asm volatile("" ::: "memory");
}

struct Epi1 {
    static constexpr bool PERM = true;
    bf16* PA; bf16* ZB; bf16* GT; const float* b_gate;
    __device__ __forceinline__ bool operator()(f32x4 (&acc)[2][2][4][2], const pg8::Unit& u, int wr, int wc, int fr, int fq) const {
        const int row0 = u.pm * 256 + wr * 64 + fr;
        int mode, ldc, colt; bf16* base;
        if (u.pn < 8) { mode = 0; base = PA; ldc = PA_LD; colt = u.pn * 256; }
        else if (u.pn < 12) { mode = 1; base = ZB; ldc = 1024; colt = (u.pn - 8) * 256; }
        else { mode = 2; base = GT; ldc = 2048; colt = (u.pn - 12) * 256; }
        const int col0 = colt + wc * 32 + 8 * fq;
        f32x4 bv[2][2];
#pragma unroll
        for (int bj = 0; bj < 2; ++bj)
#pragma unroll
            for (int n = 0; n < 2; ++n) bv[bj][n] = (mode == 2) ? *(const f32x4*)(b_gate + col0 + bj * 128 + 4 * n) : (f32x4){0.f, 0.f, 0.f, 0.f};
#pragma unroll
        for (int ai = 0; ai < 2; ++ai)
#pragma unroll
            for (int m = 0; m < 4; ++m) { bf16* rowp = base + (size_t)(row0 + ai * 128 + m * 16) * ldc + col0;
#pragma unroll
                for (int bj = 0; bj < 2; ++bj) { f32x4 v0 = acc[ai][bj][m][0] + bv[bj][0], v1 = acc[ai][bj][m][1] + bv[bj][1];
                    if (mode == 1) { f32x2 a = pg8::gelu_pk((f32x2){v0[0], v0[1]}), b = pg8::gelu_pk((f32x2){v0[2], v0[3]}), c = pg8::gelu_pk((f32x2){v1[0], v1[1]}), d = pg8::gelu_pk((f32x2){v1[2], v1[3]});
                        v0 = (f32x4){a.x, a.y, b.x, b.y}; v1 = (f32x4){c.x, c.y, d.x, d.y}; }
                    if (mode == 2) {
#pragma unroll
                        for (int j = 0; j < 4; ++j) { v0[j] = pg8::fast_sigmoid(v0[j]); v1[j] = pg8::fast_sigmoid(v1[j]); } }
                    u32x4 w; w.x = pg8::cvt_pk_bf16(v0[0], v0[1]); w.y = pg8::cvt_pk_bf16(v0[2], v0[3]); w.z = pg8::cvt_pk_bf16(v1[0], v1[1]); w.w = pg8::cvt_pk_bf16(v1[2], v1[3]);
                    *(u32x4*)(rowp + bj * 128) = w; } }
        return false;
    }
};

struct MixOrder {
    const char *YA, *YB, *WA, *WB; int G, c;
    __device__ __forceinline__ bool next(int i, pg8::Unit& u) const {
        const int L = (i >> 1) * G + c; if (L >= 256) return false;
        u.pm = L >> 2; u.pn = L & 3; u.aux = i & 1; u.rt = 0;
        u.A = ((i & 1) ? YB : YA) + (size_t)u.pm * 256 * 512 * 2; u.B = ((i & 1) ? WB : WA) + (size_t)u.pn * 256 * 512 * 2; return true;
    }
};
__device__ __forceinline__ void unpack8(const u32x4 w, float (&f)[8]) {
    f[0] = __uint_as_float(w.x << 16); f[1] = __uint_as_float(w.x & 0xffff0000u); f[2] = __uint_as_float(w.y << 16); f[3] = __uint_as_float(w.y & 0xffff0000u);
    f[4] = __uint_as_float(w.z << 16); f[5] = __uint_as_float(w.z & 0xffff0000u); f[6] = __uint_as_float(w.w << 16); f[7] = __uint_as_float(w.w & 0xffff0000u);
}
struct PanelOrder {
    const char* A; const char* Ahi; const char* B; int lda, ldb, G, c;
    __device__ __forceinline__ bool next(int i, pg8::Unit& u) const {
        const int L = i * G + c; if (L >= 256) return false;
        u.pm = L >> 2; u.pn = L & 3; u.aux = 0; u.rt = 0; u.A = (u.pm < 32 ? A : Ahi) + (size_t)u.pm * 256 * lda * 2; u.B = B + (size_t)u.pn * 256 * ldb * 2; return true;
    }
};
struct EpiMix {
    static constexpr bool PERM = true;
    const bf16* GT; bf16* MIXlo; bf16* MIXhi;
    __device__ __forceinline__ bool operator()(f32x4 (&acc)[2][2][4][2], const pg8::Unit& u, int wr, int wc, int fr, int fq) const {
        const int row0 = u.pm * 256 + wr * 64 + fr, col0 = u.pn * 256 + wc * 32 + 8 * fq;
#pragma unroll
        for (int ai = 0; ai < 2; ++ai)
#pragma unroll
            for (int m = 0; m < 4; ++m) { const size_t row = (size_t)(row0 + ai * 128 + m * 16);
#pragma unroll
                for (int bj = 0; bj < 2; ++bj) { const int c = col0 + bj * 128;
                    float gb[8]; unpack8(*(const u32x4*)(GT + row * 2048 + 1024 + c), gb);
                    if (u.aux == 0) { float ga[8]; unpack8(*(const u32x4*)(GT + row * 2048 + c), ga);
#pragma unroll
                        for (int j = 0; j < 4; ++j) { acc[ai][bj][m][0][j] *= ga[j] * __builtin_amdgcn_rcpf(gb[j]); acc[ai][bj][m][1][j] *= ga[4 + j] * __builtin_amdgcn_rcpf(gb[4 + j]); }
                    } else { const f32x4 v0 = acc[ai][bj][m][0], v1 = acc[ai][bj][m][1];
                        u32x4 w; w.x = pg8::cvt_pk_bf16(v0[0] * gb[0], v0[1] * gb[1]); w.y = pg8::cvt_pk_bf16(v0[2] * gb[2], v0[3] * gb[3]);
                        w.z = pg8::cvt_pk_bf16(v1[0] * gb[4], v1[1] * gb[5]); w.w = pg8::cvt_pk_bf16(v1[2] * gb[6], v1[3] * gb[7]);
                        bf16* dst = (row < 8192 ? MIXlo : MIXhi) + row * 1024 + c; st_wt8(dst, w.x, w.y); st_wt8(dst + 4, w.z, w.w); } } }
        return u.aux == 0;
    }
};
struct EpiX1 {
    static constexpr bool PERM = true;
    const float* x; bf16* X1;
    __device__ __forceinline__ bool operator()(f32x4 (&acc)[2][2][4][2], const pg8::Unit& u, int wr, int wc, int fr, int fq) const {
        const int row0 = u.pm * 256 + wr * 64 + fr, col0 = u.pn * 256 + wc * 32 + 8 * fq;
#pragma unroll
        for (int ai = 0; ai < 2; ++ai)
#pragma unroll
            for (int m = 0; m < 4; ++m) { const size_t off = (size_t)(row0 + ai * 128 + m * 16) * 1024 + col0;
#pragma unroll
                for (int bj = 0; bj < 2; ++bj) { const f32x4 v0 = *(const f32x4*)(x + off + bj * 128) + acc[ai][bj][m][0], v1 = *(const f32x4*)(x + off + bj * 128 + 4) + acc[ai][bj][m][1];
                    u32x4 w; w.x = pg8::cvt_pk_bf16(v0[0], v0[1]); w.y = pg8::cvt_pk_bf16(v0[2], v0[3]); w.z = pg8::cvt_pk_bf16(v1[0], v1[1]); w.w = pg8::cvt_pk_bf16(v1[2], v1[3]);
                    *(u32x4*)(X1 + off + bj * 128) = w; } }
        return false;
    }
};

__device__ __forceinline__ void moe_tables(Frame& F, const unsigned* cnt) {
    volatile LAS int* tab = (volatile LAS int*)(F.lds + TAB_OFF);
    if (F_TID == 0) { int acc = 0; for (int e = 0; e < 32; ++e) { tab[e] = acc; acc += (int)((__hip_atomic_load(cnt + e, __ATOMIC_RELAXED, __HIP_MEMORY_SCOPE_AGENT) + 255u) >> 8); } tab[32] = acc; }
    __syncthreads();
}
struct MoeOrder {
    const char* A; const char* B; LAS const int* tab; int NT, nN, G, c; size_t a_tile, b_exp, b_tile; int rt0;
    __device__ __forceinline__ bool next(int i, pg8::Unit& u) const {
        const int L = i * G + c; if (L >= NT * nN) return false;
        pg8::tile_order(L, NT, nN, u.pm, u.pn);
        int e = 0;
#pragma unroll 1
        for (int k = 1; k < 32; ++k) e += (u.pm >= tab[k]) ? 1 : 0;
        u.aux = e; u.A = rt0 >= 0 ? A : A + (size_t)u.pm * a_tile; u.rt = rt0 >= 0 ? rt0 + i * 1024 : 0; u.B = B + (size_t)e * b_exp + (size_t)u.pn * b_tile; return true;
    }
};
struct EpiAct {
    static constexpr bool PERM = true;
    bf16* ACT;
    __device__ __forceinline__ bool operator()(f32x4 (&acc)[2][2][4][2], const pg8::Unit& u, int wr, int wc, int fr, int fq) const {
        const int row0 = u.pm * 256 + wr * 64 + fr, col0 = u.pn * 128 + wc * 32 + 8 * fq;
#pragma unroll
        for (int ai = 0; ai < 2; ++ai)
#pragma unroll
            for (int m = 0; m < 4; ++m) { float o[8];
#pragma unroll
                for (int n = 0; n < 2; ++n)
#pragma unroll
                    for (int j = 0; j < 4; ++j) { const float g = acc[ai][0][m][n][j], up = acc[ai][1][m][n][j]; o[4 * n + j] = g * pg8::fast_sigmoid(g) * up; }
                u32x4 w; w.x = pg8::cvt_pk_bf16(o[0], o[1]); w.y = pg8::cvt_pk_bf16(o[2], o[3]); w.z = pg8::cvt_pk_bf16(o[4], o[5]); w.w = pg8::cvt_pk_bf16(o[6], o[7]);
                *(u32x4*)(ACT + (size_t)(row0 + ai * 128 + m * 16) * 256 + col0) = w; }
        return false;
    }
};
struct EpiYE {
    static constexpr bool PERM = true;
    bf16* YE;
    __device__ __forceinline__ bool operator()(f32x4 (&acc)[2][2][4][2], const pg8::Unit& u, int wr, int wc, int fr, int fq) const {
        const int row0 = u.pm * 256 + wr * 64 + fr, col0 = u.pn * 256 + wc * 32 + 8 * fq;
#pragma unroll
        for (int ai = 0; ai < 2; ++ai)
#pragma unroll
            for (int m = 0; m < 4; ++m) { bf16* rowp = YE + (size_t)(row0 + ai * 128 + m * 16) * 1024 + col0;
#pragma unroll
                for (int bj = 0; bj < 2; ++bj) { const f32x4 v0 = acc[ai][bj][m][0], v1 = acc[ai][bj][m][1];
                    u32x4 w; w.x = pg8::cvt_pk_bf16(v0[0], v0[1]); w.y = pg8::cvt_pk_bf16(v0[2], v0[3]); w.z = pg8::cvt_pk_bf16(v1[0], v1[1]); w.w = pg8::cvt_pk_bf16(v1[2], v1[3]);
                    *(u32x4*)(rowp + bj * 128) = w; } }
        return false;
    }
};

constexpr size_t WS_BON = 1 * MiB;
constexpr size_t WS_PHIT = 16 * MiB, WS_QT = 32 * MiB, WS_LT = 48 * MiB, WS_YL = 64 * MiB;
__device__ __forceinline__ float bflo(unsigned w) { return __uint_as_float(w << 16); }
__device__ __forceinline__ float bfhi(unsigned w) { return __uint_as_float(w & 0xffff0000u); }
struct ScanBufs { const bf16 *R, *KK, *BV, *KM, *LW, *VV, *GG; bf16 *PHIT, *QT, *LT, *YL; bf16 *XF; bf16* YA; };

typedef _Float16 h2_t __attribute__((ext_vector_type(2)));
__device__ __forceinline__ unsigned pkh(float a, float b) { h2_t v = {(_Float16)a, (_Float16)b}; return __builtin_bit_cast(unsigned, v); }
__device__ __forceinline__ float h_lo(unsigned w) { return (float)__builtin_bit_cast(h2_t, w)[0]; }
__device__ __forceinline__ float h_hi(unsigned w) { return (float)__builtin_bit_cast(h2_t, w)[1]; }
#define WKV_HPAIR2(P0, P1, L0, L1, E0, E1, B0, B1, K0, K1, R0, R1, A0, A1) \
    asm volatile( \
        "v_pk_fma_f16 %0, %0, %8, %0\n\tv_pk_fma_f16 %2, %2, %8, %2\n\tv_pk_fma_f16 %1, %1, %9, %1\n\tv_pk_fma_f16 %3, %3, %9, %3\n\t" \
        "v_pk_fma_f16 %0, %10, %18, %0\n\tv_pk_fma_f16 %2, %10, %19, %2\n\tv_pk_fma_f16 %1, %11, %18, %1\n\tv_pk_fma_f16 %3, %11, %19, %3\n\t" \
        "v_pk_fma_f16 %2, %12, %20, %2\n\tv_pk_fma_f16 %3, %13, %20, %3\n\t" \
        "v_pk_fma_f16 %4, %0, %14, %4\n\tv_pk_fma_f16 %6, %0, %16, %6\n\tv_pk_fma_f16 %5, %2, %14, %5\n\tv_pk_fma_f16 %7, %2, %16, %7\n\t" \
        "v_pk_fma_f16 %4, %1, %15, %4\n\tv_pk_fma_f16 %6, %1, %17, %6\n\tv_pk_fma_f16 %5, %3, %15, %5\n\tv_pk_fma_f16 %7, %3, %17, %7" \
        : "+v"(P0), "+v"(P1), "+v"(L0), "+v"(L1), "+v"(q), "+v"(yl), "+v"(sa2p), "+v"(sa2l) \
        : "v"(E0), "v"(E1), "v"(B0), "v"(B1), "v"(K0), "v"(K1), "v"(R0), "v"(R1), "v"(A0), "v"(A1), "v"(sap2), "v"(sal2), "v"(vv2))

__device__ __forceinline__ void scan_pass1_h(Frame& F, const ScanBufs& B) {
    LAS unsigned char* wl = F.lds + F.wave * 8192;
    const int lane = F_LANE, h = F.wave;
    for (int bc = F.vcu; bc < 256; bc += F.G) {
        const int b = bc >> 5, c = bc & 31; const size_t m0 = (size_t)b * T + c * 64; const int uid = (b * 8 + h) * 32 + c;
        unsigned phi[32], l[32]; unsigned one = 0x3C00u; asm volatile("" : "+v"(one));
#pragma unroll
        for (int p = 0; p < 32; ++p) { phi[p] = (lane == 2 * p ? one : 0u) | (lane == 2 * p + 1 ? (one << 16) : 0u); l[p] = 0u; }
        float sa_p = -bf2f(B.KK[m0 * AW + h * 64 + lane]), sa_l = 0.f;
        const int ts = lane >> 3, c0 = 8 * (lane & 7);
        const size_t goff = (m0 + ts) * AW + h * 64 + c0;
        u32x4 pr[6];
        pr[0] = *(const u32x4*)(B.LW + goff); pr[1] = *(const u32x4*)(B.BV + goff); pr[2] = *(const u32x4*)(B.KM + goff); pr[3] = *(const u32x4*)(B.R + goff);
        pr[4] = *(const u32x4*)(B.KK + goff + AW); pr[5] = *(const u32x4*)(B.VV + goff);
        for (int sb = 0; sb < 8; ++sb) {
            asm volatile("" ::: "memory");
#pragma unroll
            for (int v = 0; v < 5; ++v) { float f[8]; unpack8(pr[v], f);
                if (v == 0) {
#pragma unroll
                    for (int i = 0; i < 8; ++i) f[i] = __expf(f[i]) - 1.f; }
                if (v == 4) {
#pragma unroll
                    for (int i = 0; i < 8; ++i) f[i] = -f[i]; }
                *(LAS u32x4*)(wl + (v * 8 + ts) * 128 + 2 * c0) = (u32x4){pkh(f[0], f[1]), pkh(f[2], f[3]), pkh(f[4], f[5]), pkh(f[6], f[7])}; }
            { float f[8]; unpack8(pr[5], f); LAS u32x4* dst = (LAS u32x4*)(wl + 5120 + (ts * 64 + c0) * 4);
              dst[0] = (u32x4){pkh(f[0], f[0]), pkh(f[1], f[1]), pkh(f[2], f[2]), pkh(f[3], f[3])}; dst[1] = (u32x4){pkh(f[4], f[4]), pkh(f[5], f[5]), pkh(f[6], f[6]), pkh(f[7], f[7])}; }
            asm volatile("" ::: "memory");
            if (sb < 7) { const size_t g2 = goff + (size_t)(sb + 1) * 8 * AW;
                pr[0] = *(const u32x4*)(B.LW + g2); pr[1] = *(const u32x4*)(B.BV + g2); pr[2] = *(const u32x4*)(B.KM + g2); pr[3] = *(const u32x4*)(B.R + g2);
                pr[4] = *(const u32x4*)(B.KK + g2 + AW); pr[5] = *(const u32x4*)(B.VV + g2); }
            {
                u32x4 bufE[3], bufB[3], bufK[3], bufR[3], bufA[3];
#define H_LOAD(slot, f_) do { const LAS unsigned char* p_ = wl + ((f_) >> 3) * 128 + ((f_) & 7) * 16; \
                    bufE[slot] = *(const LAS u32x4*)(p_); bufB[slot] = *(const LAS u32x4*)(p_ + 1024); bufK[slot] = *(const LAS u32x4*)(p_ + 2048); \
                    bufR[slot] = *(const LAS u32x4*)(p_ + 3072); bufA[slot] = *(const LAS u32x4*)(p_ + 4096); } while (0)
                H_LOAD(0, 0); H_LOAD(1, 1);
                unsigned vv2 = *(const LAS unsigned*)(wl + 5120 + lane * 4), vv2n = 0u;
                unsigned sap2 = pkh(sa_p, sa_p), sal2 = pkh(sa_l, sa_l);
                unsigned q = 0u, yl = 0u, sa2p = 0u, sa2l = 0u;
#pragma unroll
                for (int f = 0; f < 64; ++f) { const int tt = f >> 3, g = f & 7, sl = f % 3;
                    if (f + 2 < 64) H_LOAD((f + 2) % 3, f + 2);
                    if (g == 6 && tt < 7) vv2n = *(const LAS unsigned*)(wl + 5120 + ((tt + 1) * 64 + lane) * 4);
                    __builtin_amdgcn_sched_barrier(0);
                    WKV_HPAIR2(phi[4 * g], phi[4 * g + 1], l[4 * g], l[4 * g + 1], bufE[sl][0], bufE[sl][1], bufB[sl][0], bufB[sl][1], bufK[sl][0], bufK[sl][1], bufR[sl][0], bufR[sl][1], bufA[sl][0], bufA[sl][1]);
                    WKV_HPAIR2(phi[4 * g + 2], phi[4 * g + 3], l[4 * g + 2], l[4 * g + 3], bufE[sl][2], bufE[sl][3], bufB[sl][2], bufB[sl][3], bufK[sl][2], bufK[sl][3], bufR[sl][2], bufR[sl][3], bufA[sl][2], bufA[sl][3]);
                    __builtin_amdgcn_sched_barrier(0);
                    if (g == 7) { const int t = sb * 8 + tt;
                        B.QT[(size_t)uid * 4096 + t * 64 + lane] = f2bf(h_lo(q) + h_hi(q));
                        B.YL[(size_t)uid * 4096 + t * 64 + lane] = f2bf(h_lo(yl) + h_hi(yl));
                        sa_p = h_lo(sa2p) + h_hi(sa2p); sa_l = h_lo(sa2l) + h_hi(sa2l);
                        sap2 = pkh(sa_p, sa_p); sal2 = pkh(sa_l, sa_l); vv2 = vv2n; q = 0u; yl = 0u; sa2p = 0u; sa2l = 0u; }
                }
#undef H_LOAD
            }
        }
#pragma unroll
        for (int p = 0; p < 32; ++p) { const size_t o = (size_t)uid * 4096 + (2 * p) * 64 + lane;
            B.PHIT[o] = f2bf(h_lo(phi[p])); B.PHIT[o + 64] = f2bf(h_hi(phi[p])); B.LT[o] = f2bf(h_lo(l[p])); B.LT[o + 64] = f2bf(h_hi(l[p])); }
    }
}

typedef float f32x16 __attribute__((ext_vector_type(16)));
__device__ __forceinline__ bf16x8 acc_frag(const f32x16& x, int s) {
    u32x4 w; w.x = pg8::cvt_pk_bf16(x[8 * s], x[8 * s + 1]); w.y = pg8::cvt_pk_bf16(x[8 * s + 2], x[8 * s + 3]); w.z = pg8::cvt_pk_bf16(x[8 * s + 4], x[8 * s + 5]); w.w = pg8::cvt_pk_bf16(x[8 * s + 6], x[8 * s + 7]);
    return __builtin_bit_cast(bf16x8, w);
}
__device__ __forceinline__ bf16x8 row_frag(const bf16* row, int s, int hh) {
    const u32x2 a = *(const u32x2*)(row + 16 * s + 4 * hh), b = *(const u32x2*)(row + 16 * s + 8 + 4 * hh);
    u32x4 w; w.x = a.x; w.y = a.y; w.z = b.x; w.w = b.y; return __builtin_bit_cast(bf16x8, w);
}
__device__ __forceinline__ void scan_pass2(Frame& F, const ScanBufs& B) {
    if (F.wave >= 2) return;
    const int it = F.wave, lane = F_LANE, l31 = lane & 31, hh = lane >> 5;
    for (int bh = F.vcu; bh < 64; bh += F.G) {
        f32x16 X[2];
#pragma unroll
        for (int jt = 0; jt < 2; ++jt)
#pragma unroll
            for (int r = 0; r < 16; ++r) X[jt][r] = 0.f;
        f32x16 Ln[2]; bf16x8 Pf[2][2][2];
#define P2_LOAD(c_) do { const size_t ub_ = ((size_t)bh * 32 + (c_)) * 4096; \
            _Pragma("unroll") for (int j2 = 0; j2 < 2; ++j2) { \
                _Pragma("unroll") for (int r = 0; r < 16; ++r) Ln[j2][r] = bf2f(B.LT[ub_ + (size_t)(32 * j2 + (r & 3) + 8 * (r >> 2) + 4 * hh) * 64 + 32 * it + l31]); \
                const bf16* prow_ = B.PHIT + ub_ + (size_t)(32 * j2 + l31) * 64; \
                _Pragma("unroll") for (int jt = 0; jt < 2; ++jt) _Pragma("unroll") for (int s = 0; s < 2; ++s) Pf[j2][jt][s] = row_frag(prow_ + 32 * jt, s, hh); } } while (0)
        P2_LOAD(0);
#pragma unroll 1
        for (int c = 0; c < 32; ++c) { const size_t ub = ((size_t)bh * 32 + c) * 4096;
            bf16x8 xf[2][2];
#pragma unroll
            for (int jt = 0; jt < 2; ++jt)
#pragma unroll
                for (int s = 0; s < 2; ++s) { xf[jt][s] = acc_frag(X[jt], s);
                    *(bf16x8*)(B.XF + ub + (size_t)(((it * 2 + jt) * 2 + s) * 64 + lane) * 8) = xf[jt][s]; }
            f32x16 Xn[2] = {Ln[0], Ln[1]}; bf16x8 Pc[2][2][2];
#pragma unroll
            for (int j2 = 0; j2 < 2; ++j2)
#pragma unroll
                for (int jt = 0; jt < 2; ++jt)
#pragma unroll
                    for (int s = 0; s < 2; ++s) Pc[j2][jt][s] = Pf[j2][jt][s];
            if (c < 31) P2_LOAD(c + 1);
#pragma unroll
            for (int j2 = 0; j2 < 2; ++j2)
#pragma unroll
                for (int jt = 0; jt < 2; ++jt)
#pragma unroll
                    for (int s = 0; s < 2; ++s) Xn[j2] = __builtin_amdgcn_mfma_f32_32x32x16_bf16(Pc[j2][jt][s], xf[jt][s], Xn[j2], 0, 0, 0);
            X[0] = Xn[0]; X[1] = Xn[1];
        }
#undef P2_LOAD
    }
}
__device__ __forceinline__ void scan_pass3(Frame& F, const ScanBufs& B, const float* __restrict__ BON, const float* __restrict__ lnx_g, const float* __restrict__ lnx_b) {
    const int lane = F_LANE, l31 = lane & 31, hh = lane >> 5, h = F.wave;
    constexpr int TL = 72;
    LAS bf16* tv = (LAS bf16*)(F.lds + h * 16384); LAS bf16* tg = tv + 32 * TL; LAS bf16* to = tg + 32 * TL;
    const int ctok = lane >> 3, cch = 8 * (lane & 7);
    for (int bc = F.vcu; bc < 256; bc += F.G) {
        const int b = bc >> 5, c = bc & 31; const size_t m0 = (size_t)b * T + c * 64; const size_t ub = ((size_t)(b * 8 + h) * 32 + c) * 4096;
        bf16x8 xa[2][2][2];
#pragma unroll
        for (int it = 0; it < 2; ++it)
#pragma unroll
            for (int jt = 0; jt < 2; ++jt)
#pragma unroll
                for (int s = 0; s < 2; ++s) xa[it][jt][s] = *(const bf16x8*)(B.XF + ub + (size_t)(((it * 2 + jt) * 2 + s) * 64 + lane) * 8);
#pragma unroll 1
        for (int tt = 0; tt < 2; ++tt) { const int t = 32 * tt + l31; const size_t m = m0 + t;
            u32x4 rv[4], rg[4];
#pragma unroll
            for (int i = 0; i < 4; ++i) { const size_t o = (m0 + 32 * tt + ctok + 8 * i) * AW + h * 64 + cch; rv[i] = *(const u32x4*)(B.VV + o); rg[i] = *(const u32x4*)(B.GG + o); }
            const float bsum = BON[m * 8 + h];
            f32x16 Y[2];
#pragma unroll
            for (int it = 0; it < 2; ++it)
#pragma unroll
                for (int g4 = 0; g4 < 4; ++g4) { const u32x2 y4 = *(const u32x2*)(B.YL + ub + (size_t)t * 64 + 32 * it + 8 * g4 + 4 * hh);
                    Y[it][4 * g4] = bflo(y4.x); Y[it][4 * g4 + 1] = bfhi(y4.x); Y[it][4 * g4 + 2] = bflo(y4.y); Y[it][4 * g4 + 3] = bfhi(y4.y); }
            const bf16* qrow = B.QT + ub + (size_t)t * 64;
#pragma unroll
            for (int jt = 0; jt < 2; ++jt)
#pragma unroll
                for (int s = 0; s < 2; ++s) { const bf16x8 qb = row_frag(qrow + 32 * jt, s, hh);
#pragma unroll
                    for (int it = 0; it < 2; ++it) Y[it] = __builtin_amdgcn_mfma_f32_32x32x16_bf16(xa[it][jt][s], qb, Y[it], 0, 0, 0); }
            asm volatile("" ::: "memory");
#pragma unroll
            for (int i = 0; i < 4; ++i) { *(LAS u32x4*)(tv + (ctok + 8 * i) * TL + cch) = rv[i]; *(LAS u32x4*)(tg + (ctok + 8 * i) * TL + cch) = rg[i]; }
            float sum = 0.f;
#pragma unroll
            for (int it = 0; it < 2; ++it)
#pragma unroll
                for (int r = 0; r < 16; ++r) sum += Y[it][r];
            sum += __shfl_xor(sum, 32);
            const float mean = sum * (1.f / 64.f); float sq = 0.f;
#pragma unroll
            for (int it = 0; it < 2; ++it)
#pragma unroll
                for (int r = 0; r < 16; ++r) { const float d = Y[it][r] - mean; sq += d * d; }
            sq += __shfl_xor(sq, 32);
            const float rstd = rsqrtf(sq * (1.f / 64.f) + 64e-5f);
            asm volatile("s_waitcnt lgkmcnt(0)" ::: "memory");
#pragma unroll
            for (int it = 0; it < 2; ++it)
#pragma unroll
                for (int g4 = 0; g4 < 4; ++g4) { const int cl = 32 * it + 8 * g4 + 4 * hh, ch = h * 64 + cl;
                    const u32x2 v2 = *(const LAS u32x2*)(tv + l31 * TL + cl), g2 = *(const LAS u32x2*)(tg + l31 * TL + cl);
                    const f32x4 lg = *(const f32x4*)(lnx_g + ch), lb = *(const f32x4*)(lnx_b + ch);
                    const float vv[4] = {bflo(v2.x), bfhi(v2.x), bflo(v2.y), bfhi(v2.y)};
                    const float gg[4] = {bflo(g2.x), bfhi(g2.x), bflo(g2.y), bfhi(g2.y)};
                    float o4[4];
#pragma unroll
                    for (int i = 0; i < 4; ++i) { const float yn = (Y[it][4 * g4 + i] - mean) * rstd * lg[i] + lb[i]; o4[i] = (yn + bsum * vv[i]) * gg[i]; }
                    u32x2 w; w.x = pg8::cvt_pk_bf16(o4[0], o4[1]); w.y = pg8::cvt_pk_bf16(o4[2], o4[3]);
                    *(LAS u32x2*)(to + l31 * TL + cl) = w;
                    if (g4 & 1) asm volatile("" ::: "memory"); }
            asm volatile("s_waitcnt lgkmcnt(0)" ::: "memory");
#pragma unroll
            for (int i = 0; i < 4; ++i) { const u32x4 w = *(const LAS u32x4*)(to + (ctok + 8 * i) * TL + cch); bf16* dst = B.YA + (m0 + 32 * tt + ctok + 8 * i) * AW + h * 64 + cch;
                st_wt8(dst, w.x, w.y); st_wt8(dst + 4, w.z, w.w); }
            asm volatile("s_waitcnt lgkmcnt(0)" ::: "memory");
        }
    }
}

constexpr size_t WS_WRT = 512 * 1024;
constexpr size_t WS_W2T = 15 * MiB + 512 * 1024, WS_A2T = WS_W2T + 64 * 1024, WS_G2T = WS_A2T + 64 * 1024, WS_WSB = WS_G2T + 160 * 1024;
constexpr int XS_LD = 296, VT_LD = 136;
struct PrepBufs { const bf16* PA; const float *mu, *w0, *a0, *k_k, *k_a; const bf16 *W2T, *A2T, *G2T; bf16 *R, *KK, *BV, *KM, *LW, *VV, *GG; const float* r_k; float* BON; };
__device__ __forceinline__ f32x4 lerp4(const bf16* cur, const float* mu, bool first) {
    const u32x2 c = *(const u32x2*)cur; u32x2 p = *(const u32x2*)(cur - PA_LD); if (first) { p.x = 0u; p.y = 0u; }
    const f32x4 m4 = *(const f32x4*)mu; const f32x4 cv = (f32x4){bflo(c.x), bfhi(c.x), bflo(c.y), bfhi(c.y)}, pv = (f32x4){bflo(p.x), bfhi(p.x), bflo(p.y), bfhi(p.y)};
    return cv + m4 * (pv - cv);
}
constexpr int LO_LD = 72;
__device__ __forceinline__ void prep_phase(Frame& F, const PrepBufs& P) {
    const int lane = F_LANE, tid = F_TID, l31 = lane & 31, hh = lane >> 5, h = F.wave;
    LAS bf16* xs = (LAS bf16*)F.lds;
    LAS bf16* lo = (LAS bf16*)(F.lds + 32 * XS_LD * 2) + h * (3 * 32 * LO_LD);
    const int chn = h * 64 + 8 * (lane & 7);
    for (int tl = 0; tl < 2 * ((M / 64 + F.G - 1) / F.G); ++tl) { const int u = F.vcu + (tl >> 1) * F.G; if (u >= M / 64) break; const size_t m0 = (size_t)(2 * u + (tl & 1)) * 32;
        __syncthreads();
        for (int it = tid; it < 32 * 36; it += NTHREADS) { const int tok = it / 36, c = it - tok * 36; const size_t m = m0 + tok; const bool first = (m & (T - 1)) == 0;
            const bf16* cp = P.PA + m * PA_LD + 1536 + 8 * c;
            float x[8], pv[8]; unpack8(*(const u32x4*)cp, x); unpack8(*(const u32x4*)(cp - PA_LD), pv);
            const f32x4 mu0 = *(const f32x4*)(P.mu + 1536 + 8 * c), mu1 = *(const f32x4*)(P.mu + 1536 + 8 * c + 4);
#pragma unroll
            for (int i = 0; i < 8; ++i) { const float p = first ? 0.f : pv[i]; x[i] += (i < 4 ? mu0[i & 3] : mu1[i & 3]) * (p - x[i]); }
            if (c < 8) {
#pragma unroll
                for (int i = 0; i < 8; ++i) x[i] = 1.f - 2.f * __builtin_amdgcn_rcpf(1.f + __builtin_amdgcn_exp2f(2.8853900817779268f * x[i])); }
            else if (c >= 16) {
#pragma unroll
                for (int i = 0; i < 8; ++i) x[i] = pg8::fast_sigmoid(x[i]); }
            u32x4 w; w.x = pg8::cvt_pk_bf16(x[0], x[1]); w.y = pg8::cvt_pk_bf16(x[2], x[3]); w.z = pg8::cvt_pk_bf16(x[4], x[5]); w.w = pg8::cvt_pk_bf16(x[6], x[7]);
            *(LAS u32x4*)(xs + tok * XS_LD + 8 * c) = w; }
        __syncthreads();
        const LAS bf16* xrow = xs + l31 * XS_LD + 8 * hh;
#pragma unroll
        for (int which = 0; which < 3; ++which) {
            f32x16 acc[2];
#pragma unroll
            for (int i2 = 0; i2 < 2; ++i2)
#pragma unroll
                for (int r = 0; r < 16; ++r) acc[i2][r] = 0.f;
            const bf16* WT = which == 0 ? P.A2T : (which == 1 ? P.W2T : P.G2T); const int ldw = which == 2 ? 160 : 64, nks = which == 2 ? 10 : 4, xoff = which == 0 ? 64 : (which == 1 ? 0 : 128);
#pragma unroll
            for (int ks = 0; ks < nks; ++ks) { const bf16x8 bx = *(const LAS bf16x8*)(xrow + xoff + 16 * ks);
#pragma unroll
                for (int i2 = 0; i2 < 2; ++i2) acc[i2] = __builtin_amdgcn_mfma_f32_32x32x16_bf16(*(const bf16x8*)(WT + (size_t)(h * 64 + 32 * i2 + l31) * ldw + 16 * ks + 8 * hh), bx, acc[i2], 0, 0, 0); }
#pragma unroll
            for (int i2 = 0; i2 < 2; ++i2)
#pragma unroll
                for (int g4 = 0; g4 < 4; ++g4) { const int cl = 32 * i2 + 8 * g4 + 4 * hh; float o4[4];
                    if (which == 0) { const f32x4 c4 = *(const f32x4*)(P.a0 + h * 64 + cl);
#pragma unroll
                        for (int i = 0; i < 4; ++i) o4[i] = pg8::fast_sigmoid(c4[i] + acc[i2][4 * g4 + i]); }
                    else if (which == 1) { const f32x4 c4 = *(const f32x4*)(P.w0 + h * 64 + cl);
#pragma unroll
                        for (int i = 0; i < 4; ++i) o4[i] = -0.60653066f * pg8::fast_sigmoid(c4[i] + acc[i2][4 * g4 + i]); }
                    else {
#pragma unroll
                        for (int i = 0; i < 4; ++i) o4[i] = acc[i2][4 * g4 + i]; }
                    u32x2 w; w.x = pg8::cvt_pk_bf16(o4[0], o4[1]); w.y = pg8::cvt_pk_bf16(o4[2], o4[3]);
                    *(LAS u32x2*)(lo + (which * 32 + l31) * LO_LD + cl) = w; }
        }
        asm volatile("s_waitcnt lgkmcnt(0)" ::: "memory");
        float muR[8], muK[8], muV[8], kk8[8], ka8[8], rk8[8];
        { const f32x4 f0_ = *(const f32x4*)(P.r_k + chn), f1_ = *(const f32x4*)(P.r_k + chn + 4);
#pragma unroll
          for (int i = 0; i < 4; ++i) { rk8[i] = f0_[i]; rk8[4 + i] = f1_[i]; } }
        { const f32x4 a0_ = *(const f32x4*)(P.mu + chn), a1_ = *(const f32x4*)(P.mu + chn + 4), b0_ = *(const f32x4*)(P.mu + 512 + chn), b1_ = *(const f32x4*)(P.mu + 512 + chn + 4),
                      c0_ = *(const f32x4*)(P.mu + 1024 + chn), c1_ = *(const f32x4*)(P.mu + 1024 + chn + 4), d0_ = *(const f32x4*)(P.k_k + chn), d1_ = *(const f32x4*)(P.k_k + chn + 4),
                      e0_ = *(const f32x4*)(P.k_a + chn), e1_ = *(const f32x4*)(P.k_a + chn + 4);
#pragma unroll
          for (int i = 0; i < 4; ++i) { muR[i] = a0_[i]; muR[4 + i] = a1_[i]; muK[i] = b0_[i]; muK[4 + i] = b1_[i]; muV[i] = c0_[i]; muV[4 + i] = c1_[i]; kk8[i] = d0_[i]; kk8[4 + i] = d1_[i]; ka8[i] = e0_[i]; ka8[4 + i] = e1_[i]; } }
#pragma unroll 1
        for (int i4 = 0; i4 < 4; ++i4) { const int tok = (lane >> 3) + 8 * i4; const size_t m = m0 + tok; const bool first = (m & (T - 1)) == 0;
            const bf16* cp = P.PA + m * PA_LD + chn;
            float r[8], k[8], v[8], pr[8], pk[8], pv[8];
            unpack8(*(const u32x4*)cp, r); unpack8(*(const u32x4*)(cp + 512), k); unpack8(*(const u32x4*)(cp + 1024), v);
            unpack8(*(const u32x4*)(cp - PA_LD), pr); unpack8(*(const u32x4*)(cp - PA_LD + 512), pk); unpack8(*(const u32x4*)(cp - PA_LD + 1024), pv);
            float a[8]; unpack8(*(const LAS u32x4*)(lo + tok * LO_LD + 8 * (lane & 7)), a);
            const u32x4 lwb = *(const LAS u32x4*)(lo + (32 + tok) * LO_LD + 8 * (lane & 7)), ggb = *(const LAS u32x4*)(lo + (64 + tok) * LO_LD + 8 * (lane & 7));
            float kkv[8]; float ss = 0.f;
#pragma unroll
            for (int i = 0; i < 8; ++i) { const float p0 = first ? 0.f : pr[i], p1 = first ? 0.f : pk[i], p2 = first ? 0.f : pv[i];
                r[i] += muR[i] * (p0 - r[i]); k[i] += muK[i] * (p1 - k[i]); v[i] += muV[i] * (p2 - v[i]); kkv[i] = k[i] * kk8[i]; ss += kkv[i] * kkv[i]; }
            ss += __shfl_xor(ss, 1); ss += __shfl_xor(ss, 2); ss += __shfl_xor(ss, 4);
            const float inv = 1.f / fmaxf(sqrtf(ss), 1e-12f);
            float bv[8], km[8];
            float bon = 0.f;
#pragma unroll
            for (int i = 0; i < 8; ++i) { kkv[i] *= inv; bv[i] = kkv[i] * a[i]; km[i] = k[i] * (1.f + (a[i] - 1.f) * ka8[i]); bon += r[i] * km[i] * rk8[i]; }
            bon += __shfl_xor(bon, 1); bon += __shfl_xor(bon, 2); bon += __shfl_xor(bon, 4);
            if ((lane & 7) == 0) P.BON[m * 8 + h] = bon;
            const size_t o = m * AW + chn; u32x4 w;
            w.x = pg8::cvt_pk_bf16(r[0], r[1]); w.y = pg8::cvt_pk_bf16(r[2], r[3]); w.z = pg8::cvt_pk_bf16(r[4], r[5]); w.w = pg8::cvt_pk_bf16(r[6], r[7]); *(u32x4*)(P.R + o) = w;
            w.x = pg8::cvt_pk_bf16(kkv[0], kkv[1]); w.y = pg8::cvt_pk_bf16(kkv[2], kkv[3]); w.z = pg8::cvt_pk_bf16(kkv[4], kkv[5]); w.w = pg8::cvt_pk_bf16(kkv[6], kkv[7]); *(u32x4*)(P.KK + o) = w;
            w.x = pg8::cvt_pk_bf16(bv[0], bv[1]); w.y = pg8::cvt_pk_bf16(bv[2], bv[3]); w.z = pg8::cvt_pk_bf16(bv[4], bv[5]); w.w = pg8::cvt_pk_bf16(bv[6], bv[7]); *(u32x4*)(P.BV + o) = w;
            w.x = pg8::cvt_pk_bf16(km[0], km[1]); w.y = pg8::cvt_pk_bf16(km[2], km[3]); w.z = pg8::cvt_pk_bf16(km[4], km[5]); w.w = pg8::cvt_pk_bf16(km[6], km[7]); *(u32x4*)(P.KM + o) = w;
            w.x = pg8::cvt_pk_bf16(v[0], v[1]); w.y = pg8::cvt_pk_bf16(v[2], v[3]); w.z = pg8::cvt_pk_bf16(v[4], v[5]); w.w = pg8::cvt_pk_bf16(v[6], v[7]); *(u32x4*)(P.VV + o) = w;
            *(u32x4*)(P.LW + o) = lwb; *(u32x4*)(P.GG + o) = ggb;
        }
    }
}
__device__ __forceinline__ void gmlp_phase(Frame& F, const bf16* __restrict__ ZB, const float* __restrict__ lnv_g, const float* __restrict__ lnv_b, const bf16* __restrict__ WSB, const float* __restrict__ b_s, bf16* YB, unsigned* queue) {
    const int lane = F_LANE, l31 = lane & 31, hh = lane >> 5, tid = F_TID;
    LAS bf16* vt = (LAS bf16*)F.lds;
    LAS float* st = (LAS float*)(F.lds + 128 * VT_LD * 2);
    volatile LAS int* qw = (volatile LAS int*)(F.lds + TAB_OFF + 192);
    for (;;) {
        __syncthreads();
        if (tid == 0) *qw = (int)__hip_atomic_fetch_add(queue, 1u, __ATOMIC_RELAXED, __HIP_MEMORY_SCOPE_AGENT);
        __syncthreads();
        const int unit = *qw; if (unit >= 512) break;
        const int g = unit & 3; const size_t m0 = (size_t)(unit >> 2) * 128;
#pragma unroll 1
        for (int i0_ = 0; i0_ < 16; i0_ += 8) {
            u32x4 raw[8];
#pragma unroll
            for (int i = 0; i < 8; ++i) raw[i] = *(const u32x4*)(ZB + (m0 + 16 * F.wave + i0_ + i) * 1024 + 512 + 8 * lane);
#pragma unroll
            for (int i = 0; i < 8; ++i) { const int sidx = 16 * F.wave + i0_ + i; float f[8]; unpack8(raw[i], f);
                float sum = 0.f;
#pragma unroll
                for (int j = 0; j < 8; ++j) sum += f[j];
                const float mean = wave_sum(sum) * (1.f / 512.f); float q = 0.f;
#pragma unroll
                for (int j = 0; j < 8; ++j) { const float d = f[j] - mean; q += d * d; }
                const float var = wave_sum(q) * (1.f / 512.f);
                if (lane == 0) { st[2 * sidx] = mean; st[2 * sidx + 1] = rsqrtf(var + 1e-5f); } } }
        __syncthreads();
        { u32x4 raw[4];
#pragma unroll
          for (int q4 = 0; q4 < 4; ++q4) { const int it = tid + q4 * NTHREADS; raw[q4] = *(const u32x4*)(ZB + (m0 + (it >> 4)) * 1024 + 512 + g * 128 + 8 * (it & 15)); }
#pragma unroll
          for (int q4 = 0; q4 < 4; ++q4) { const int it = tid + q4 * NTHREADS; const int sidx = it >> 4, c = it & 15; const int ch = g * 128 + 8 * c;
            float f[8]; unpack8(raw[q4], f);
            const float mean = st[2 * sidx], rstd = st[2 * sidx + 1];
            const f32x4 g0 = *(const f32x4*)(lnv_g + ch), g1 = *(const f32x4*)(lnv_g + ch + 4), b0 = *(const f32x4*)(lnv_b + ch), b1 = *(const f32x4*)(lnv_b + ch + 4);
#pragma unroll
            for (int j = 0; j < 8; ++j) { const float gv = j < 4 ? g0[j & 3] : g1[j & 3], bv = j < 4 ? b0[j & 3] : b1[j & 3];
                vt[(8 * c + j) * VT_LD + sidx] = f2bf((f[j] - mean) * rstd * gv + bv); } } }
        __syncthreads();
        const int tile_t = F.wave & 3;
#pragma unroll 1
        for (int dd = 0; dd < 2; ++dd) { const int tile_d = 2 * (F.wave >> 2) + dd;
            f32x16 acc;
#pragma unroll
            for (int r = 0; r < 16; ++r) acc[r] = 0.f;
            const LAS bf16* arow = vt + (32 * tile_d + l31) * VT_LD + 8 * hh; const bf16* brow = WSB + (size_t)(g * 128 + 32 * tile_t + l31) * 128 + 8 * hh;
            for (int ks = 0; ks < 2 * (tile_t + 1); ++ks) acc = __builtin_amdgcn_mfma_f32_32x32x16_bf16(*(const LAS bf16x8*)(arow + 16 * ks), *(const bf16x8*)(brow + 16 * ks), acc, 0, 0, 0);
            const int t = 32 * tile_t + l31; const size_t m = m0 + t; const float bs = b_s[g * 128 + t];
#pragma unroll
            for (int g4 = 0; g4 < 4; ++g4) { const int ch = g * 128 + 32 * tile_d + 8 * g4 + 4 * hh; const u32x2 u2 = *(const u32x2*)(ZB + m * 1024 + ch);
                u32x2 w; w.x = pg8::cvt_pk_bf16(bflo(u2.x) * (acc[4 * g4] + bs), bfhi(u2.x) * (acc[4 * g4 + 1] + bs)); w.y = pg8::cvt_pk_bf16(bflo(u2.y) * (acc[4 * g4 + 2] + bs), bfhi(u2.y) * (acc[4 * g4 + 3] + bs));
                *(u32x2*)(YB + m * AW + ch) = w; }
        }
    }
}

__global__ void __launch_bounds__(NTHREADS, 2) mega(Args args) {
    extern __shared__ __attribute__((aligned(16))) unsigned char lds_raw[];
    Frame F; F.lds = (LAS unsigned char*)lds_raw;
    F.wave = __builtin_amdgcn_readfirstlane((int)(threadIdx.x >> 6));
    F.G = gridDim.x; { const int bx = blockIdx.x; F.vcu = (F.G % 8 == 0) ? (bx % 8) * (F.G / 8) + bx / 8 : bx; }
    unsigned char* ws = args.ws;
    unsigned* ctl = (unsigned*)(ws + WS_CTL);
    for (int u = F_TID; u < (LDS_BYTES - LDSCTL_OFF) / 4; u += NTHREADS) ((LAS unsigned*)(F.lds + LDSCTL_OFF))[u] = 0u;
    __syncthreads();
    XcdBarrier bar = xcd_barrier_post(ctl + CW_BAR + args.li * XCD_BAR_WORDS, (volatile LAS unsigned*)(F.lds + MISC_OFF) + 8);
    const int lo = args.ph_lo, hi = args.ph_hi;
#ifndef ONLY_PH
#define ONLY_PH -1
#endif
#define IN(k) ((ONLY_PH < 0 || ONLY_PH == (k)) && lo <= (k) && (k) < hi)
#define SEAM(k) do { if (IN(k) && IN((k) + 1)) { xcd_barrier(bar); if (REP_PH == 100 + (k)) xcd_barrier(bar); } } while (0)
    bf16* WIN = (bf16*)(ws + WS_WIN); bf16* WOA = (bf16*)(ws + WS_WOA); bf16* WOB = (bf16*)(ws + WS_WOB); bf16* WOUT = (bf16*)(ws + WS_WOUT);
    bf16* H1 = (bf16*)args.out;
    bf16* PA = (bf16*)(ws + WS_PA), *ZB = (bf16*)(ws + WS_ZB), *GT = (bf16*)(ws + WS_GT);

    for (int rep_ = 0; rep_ < (REP_PH == PH_P0 ? 2 : 1); ++rep_) if (IN(PH_P0)) {
        LAS float* scr = (LAS float*)(F.lds + F.wave * 16384);
        const int gw = F.vcu * NWAVES + F.wave, NGW = F.G * NWAVES;
        constexpr int I_IN = 16 * 153, I_OA = 8 * 32, I_OUT = 16 * 32, NITEMS = I_IN + 2 * I_OA + I_OUT;
        for (int it = gw; it < NITEMS; it += NGW) {
            int r = it;
            if (r < I_IN) { const int kb = r / 153, nb = r % 153; p0_transpose_item(args.in[2], 1024, IN_COLS, WIN, 1024, (32 * nb >= A_COLS) ? 224 : 0, scr, kb, nb, F_LANE); continue; } r -= I_IN;
            if (r < I_OA) { p0_transpose_item(args.in[15], 512, 1024, WOA, 512, 0, scr, r / 32, r % 32, F_LANE); continue; } r -= I_OA;
            if (r < I_OA) { p0_transpose_item(args.in[20], 512, 1024, WOB, 512, 0, scr, r / 32, r % 32, F_LANE); continue; } r -= I_OA;
            p0_transpose_item(args.in[21], 1024, 1024, WOUT, 1024, 0, scr, r / 32, r % 32, F_LANE);
        }
        for (int i = gw * 64 + F_LANE; i < 224 * 1024 / 8; i += NGW * 64) ((u32x4*)(WIN + (size_t)A_COLS * 1024))[i] = (u32x4){0u, 0u, 0u, 0u};
        { bf16* W2T = (bf16*)(ws + WS_W2T); bf16* A2T = (bf16*)(ws + WS_A2T); bf16* G2T = (bf16*)(ws + WS_G2T); bf16* WSB = (bf16*)(ws + WS_WSB);
          const int gt = gw * 64 + F_LANE, NT_ = NGW * 64;
          for (int i = gt; i < 512 * 64; i += NT_) { const int n = i >> 6, k = i & 63; W2T[i] = f2bf(args.in[6][k * 512 + n]); A2T[i] = f2bf(args.in[8][k * 512 + n]); }
          for (int i = gt; i < 512 * 160; i += NT_) { const int n = i / 160, k = i - n * 160; G2T[i] = f2bf(args.in[9][k * 512 + n]); }
          { bf16* WRT = (bf16*)(ws + WS_WRT); const float* w_rg = args.in[23]; const float* w_re = args.in[25];
            for (int i = gt; i < 64 * 1024; i += NT_) { const int n = i >> 10, k = i & 1023;
                WRT[i] = n < 32 ? f2bf(w_re[((size_t)(n >> 3) * 1024 + k) * 8 + (n & 7)]) : (n < 36 ? f2bf(w_rg[k * 4 + (n - 32)]) : (bf16)0); } }
          for (int i = gt; i < 4 * 128 * 128; i += NT_) { const int tq = (i >> 7) & 127, sq = i & 127; WSB[i] = sq <= tq ? f2bf(args.in[18][i]) : (bf16)0; } }
        const float* x = args.in[0]; const float* g1 = args.in[1];
        for (int m = gw; m < M; m += NGW) {
            const f32x4* xr = (const f32x4*)(x + (size_t)m * D) + F_LANE;
            f32x4 v[4]; float s = 0.f;
#pragma unroll
            for (int j = 0; j < 4; ++j) { v[j] = xr[64 * j]; s += (v[j].x * v[j].x + v[j].y * v[j].y) + (v[j].z * v[j].z + v[j].w * v[j].w); }
            const float rs = rsqrtf(wave_sum(s) * (1.f / D) + 1e-6f);
            u32x2* o8 = (u32x2*)(H1 + (size_t)m * D) + F_LANE;
#pragma unroll
            for (int j = 0; j < 4; ++j) { const f32x4 gg = *((const f32x4*)g1 + F_LANE + 64 * j);
                u32x2 w; w.x = pk2(v[j].x * rs * gg.x, v[j].y * rs * gg.y); w.y = pk2(v[j].z * rs * gg.z, v[j].w * rs * gg.w); o8[64 * j] = w; }
        }
    }
    SEAM(PH_P0);
    for (int rep_ = 0; rep_ < (REP_PH == PH_GEMM1 ? 2 : 1); ++rep_) if (IN(PH_GEMM1)) {
        pg8::Gemm g{D, D, D}; pg8::StaticOrder S; S.init(H1, WIN, D, D, M, N1, F.G, (int)blockIdx.x);
        Epi1 E{PA, ZB, GT, args.in[3]};
        pg8::gemm_phase<Epi1, pg8::StaticOrder, true>(F.lds, g, S, E);
    }
    SEAM(PH_GEMM1);
    for (int rep_ = 0; rep_ < (REP_PH == PH_PREP ? 2 : 1); ++rep_) if (IN(PH_PREP)) {
        PrepBufs PB{PA, args.in[4], args.in[5], args.in[7], args.in[10], args.in[11], (const bf16*)(ws + WS_W2T), (const bf16*)(ws + WS_A2T), (const bf16*)(ws + WS_G2T),
                    (bf16*)args.out, (bf16*)((char*)args.out + 16 * MiB), (bf16*)((char*)args.out + 32 * MiB), (bf16*)((char*)args.out + 48 * MiB), (bf16*)(ws + WS_LW), (bf16*)(ws + WS_VV), (bf16*)(ws + WS_GG), args.in[12], (float*)(ws + WS_BON)};
#ifndef NO_PREP
        prep_phase(F, PB);
#endif
    }
    SEAM(PH_PREP);
    ScanBufs SB{(const bf16*)args.out, (const bf16*)((char*)args.out + 16 * MiB), (const bf16*)((char*)args.out + 32 * MiB), (const bf16*)((char*)args.out + 48 * MiB),
                (const bf16*)(ws + WS_LW), (const bf16*)(ws + WS_VV), (const bf16*)(ws + WS_GG), (bf16*)(ws + WS_PHIT), (bf16*)(ws + WS_QT), (bf16*)(ws + WS_LT), (bf16*)(ws + WS_YL),
                (bf16*)((char*)args.out + 16 * MiB), (bf16*)(ws + WS_YA)};
#ifndef NO_S1
    for (int rep_ = 0; rep_ < (REP_PH == PH_SCAN1 ? 2 : 1); ++rep_) if (IN(PH_SCAN1)) scan_pass1_h(F, SB);
#endif
    SEAM(PH_SCAN1);
#ifndef NO_S2
    if (IN(PH_SCAN2)) {
        scan_pass2(F, SB);
        gmlp_phase(F, ZB, args.in[16], args.in[17], (const bf16*)(ws + WS_WSB), args.in[19], (bf16*)(ws + WS_YB), ctl + CW_GQ);
    }
#endif
    SEAM(PH_SCAN2);
#ifndef NO_S3
    for (int rep_ = 0; rep_ < (REP_PH == PH_SCAN3 ? 2 : 1); ++rep_) if (IN(PH_SCAN3))
        scan_pass3(F, SB, (const float*)(ws + WS_BON), args.in[13], args.in[14]);
#endif
    unsigned* gctr = ctl + CW_GRP + 64 * (F.vcu >> 2);
    if (IN(PH_SCAN3) && IN(PH_MIX)) group_sync(gctr, 4u, ctl + CW_BAR + XB_TMO);
    bf16* YB = (bf16*)(ws + WS_YB), *YA = (bf16*)(ws + WS_YA), *MIX = (bf16*)(ws + 16 * MiB), *MIXhi = (bf16*)(ws + 32 * MiB);
    bf16* X1 = (bf16*)(ws + WS_X1);
    for (int rep_ = 0; rep_ < (REP_PH == PH_MIX ? 2 : 1); ++rep_) if (IN(PH_MIX)) {
        pg8::Gemm g{AW, AW, AW}; MixOrder S{(const char*)YA, (const char*)YB, (const char*)WOA, (const char*)WOB, F.G, F.vcu};
        EpiMix E{GT, MIX, MIXhi};
        pg8::gemm_phase<EpiMix, MixOrder, true>(F.lds, g, S, E);
    }
    if (IN(PH_MIX) && IN(PH_WOUT)) group_sync(gctr, 8u, ctl + CW_BAR + XB_TMO);
    for (int rep_ = 0; rep_ < (REP_PH == PH_WOUT ? 2 : 1); ++rep_) if (IN(PH_WOUT)) {
        pg8::Gemm g{D, D, D}; PanelOrder S{(const char*)MIX, (const char*)MIXhi, (const char*)WOUT, D, D, F.G, F.vcu};
        EpiX1 E{args.in[0], X1};
        pg8::gemm_phase<EpiX1, PanelOrder, true>(F.lds, g, S, E);
    }
    SEAM(PH_WOUT);
    unsigned* cnt = ctl + CW_CNT;
    bf16* H2 = (bf16*)(ws + WS_H2M); bf16* YE = (bf16*)(ws + WS_YE); bf16* ACT = (bf16*)(ws + WS_ACT); bf16* WGU = (bf16*)args.out; bf16* WD = (bf16*)((char*)args.out + 32 * MiB);
    int2* SEL_E = (int2*)(ws + WS_SELE); float2* SEL_W = (float2*)(ws + WS_SELW); int2* SEL_P = (int2*)(ws + WS_SELP); int* LIST = (int*)(ws + WS_LIST);
    if (IN(PH_ROUTER)) {
        volatile LAS int* lcnt = (volatile LAS int*)(F.lds + TAB_OFF + 256);
        const float* g2n = args.in[22]; const float* b_rg = args.in[24]; const float* b_re = args.in[26];
        const bf16* WRT = (const bf16*)(ws + WS_WRT);
        LAS unsigned char* hb = F.lds + F.wave * 16384;
        const int lane = F_LANE, l31 = lane & 31, hh = lane >> 5;
        for (int mb = F.vcu; mb < M / 64; mb += F.G) {
            __syncthreads();
            if (F_TID < 64) lcnt[F_TID] = 0;
            __syncthreads();
#pragma unroll 1
            for (int i0_ = 0; i0_ < 8; i0_ += 4) {
                f32x4 xv[4][4];
#pragma unroll
                for (int i = 0; i < 4; ++i) { const u32x2* xr = (const u32x2*)(X1 + (size_t)(mb * 64 + F.wave * 8 + i0_ + i) * D) + lane;
#pragma unroll
                    for (int j = 0; j < 4; ++j) { const u32x2 w = xr[64 * j]; xv[i][j] = (f32x4){bflo(w.x), bfhi(w.x), bflo(w.y), bfhi(w.y)}; } }
#pragma unroll
                for (int i = 0; i < 4; ++i) { const int row = i0_ + i; const size_t m = (size_t)mb * 64 + F.wave * 8 + row; float sq = 0.f;
#pragma unroll
                    for (int j = 0; j < 4; ++j) sq += (xv[i][j].x * xv[i][j].x + xv[i][j].y * xv[i][j].y) + (xv[i][j].z * xv[i][j].z + xv[i][j].w * xv[i][j].w);
                    const float rs = rsqrtf(wave_sum(sq) * (1.f / D) + 1e-6f);
#pragma unroll
                    for (int j = 0; j < 4; ++j) { const f32x4 gg = *((const f32x4*)g2n + lane + 64 * j);
                        u32x2 w; w.x = pg8::cvt_pk_bf16(xv[i][j].x * rs * gg.x, xv[i][j].y * rs * gg.y); w.y = pg8::cvt_pk_bf16(xv[i][j].z * rs * gg.z, xv[i][j].w * rs * gg.w);
                        ((u32x2*)(H2 + m * D))[lane + 64 * j] = w;
                        *(LAS u32x2*)(hb + row * 2048 + ((((lane >> 1) + 32 * j) ^ row) << 4) + ((lane & 1) << 3)) = w; } }
            }
            asm volatile("s_waitcnt lgkmcnt(0)" ::: "memory");
            f32x16 acc[2];
#pragma unroll
            for (int ct = 0; ct < 2; ++ct)
#pragma unroll
                for (int r = 0; r < 16; ++r) acc[ct][r] = 0.f;
            const int arow = l31 & 7;
            const bf16* wrow = WRT + (size_t)l31 * 1024 + 8 * hh;
#pragma unroll 4
            for (int ks = 0; ks < 64; ++ks) { const bf16x8 af = *(const LAS bf16x8*)(hb + arow * 2048 + (((2 * ks + hh) ^ arow) << 4));
                acc[0] = __builtin_amdgcn_mfma_f32_32x32x16_bf16(af, *(const bf16x8*)(wrow + 16 * ks), acc[0], 0, 0, 0);
                acc[1] = __builtin_amdgcn_mfma_f32_32x32x16_bf16(af, *(const bf16x8*)(wrow + 32 * 1024 + 16 * ks), acc[1], 0, 0, 0); }
            asm volatile("s_waitcnt lgkmcnt(0)" ::: "memory");
            LAS float* lg = (LAS float*)hb;
#pragma unroll
            for (int r = 0; r < 4; ++r) { lg[(r + 4 * hh) * 64 + l31] = acc[0][r]; lg[(r + 4 * hh) * 64 + 32 + l31] = acc[1][r]; }
            asm volatile("s_waitcnt lgkmcnt(0)" ::: "memory");
            if (lane < 8) { const int tl = F.wave * 8 + lane; const size_t m = (size_t)mb * 64 + tl; const LAS float* lp = lg + lane * 64;
                float gl[4];
#pragma unroll
                for (int gi = 0; gi < 4; ++gi) gl[gi] = lp[32 + gi] + b_rg[gi];
                int gs = 0; float gm = gl[0];
#pragma unroll
                for (int gi = 1; gi < 4; ++gi) if (gl[gi] > gm) { gm = gl[gi]; gs = gi; }
                float den = 0.f;
#pragma unroll
                for (int gi = 0; gi < 4; ++gi) den += expf(gl[gi] - gm);
                const float gp = 1.f / den;
                float el[8];
#pragma unroll
                for (int e = 0; e < 8; ++e) el[e] = lp[gs * 8 + e] + b_re[gs * 8 + e];
                int i1 = 0; float m1 = el[0];
#pragma unroll
                for (int e = 1; e < 8; ++e) if (el[e] > m1) { m1 = el[e]; i1 = e; }
                int i2 = -1; float m2 = -INFINITY;
#pragma unroll
                for (int e = 0; e < 8; ++e) if (e != i1 && el[e] > m2) { m2 = el[e]; i2 = e; }
                const float w1 = 1.f / (1.f + expf(m2 - m1)), w2 = 1.f - w1;
                const int e1 = gs * 8 + i1, e2 = gs * 8 + i2;
                SEL_E[m] = make_int2(e1, e2); SEL_W[m] = make_float2(w1 * gp, w2 * gp);
                lcnt[64 + 2 * tl] = __hip_atomic_fetch_add((LAS int*)&lcnt[e1], 1, __ATOMIC_RELAXED, __HIP_MEMORY_SCOPE_WORKGROUP);
                lcnt[64 + 2 * tl + 1] = __hip_atomic_fetch_add((LAS int*)&lcnt[e2], 1, __ATOMIC_RELAXED, __HIP_MEMORY_SCOPE_WORKGROUP);
                lcnt[192 + 2 * tl] = e1; lcnt[192 + 2 * tl + 1] = e2; }
            __syncthreads();
            if (F_TID < 32) lcnt[32 + F_TID] = (int)__hip_atomic_fetch_add(cnt + F_TID, (unsigned)lcnt[F_TID], __ATOMIC_RELAXED, __HIP_MEMORY_SCOPE_AGENT);
            __syncthreads();
            if (F_TID < 64) { const int m = mb * 64 + F_TID; const int e1 = lcnt[192 + 2 * F_TID], e2 = lcnt[192 + 2 * F_TID + 1];
                const int p1 = lcnt[32 + e1] + lcnt[64 + 2 * F_TID], p2 = lcnt[32 + e2] + lcnt[64 + 2 * F_TID + 1];
                SEL_P[m] = make_int2(p1, p2); LIST[e1 * 16384 + p1] = m; LIST[e2 * 16384 + p2] = m; }
        }
        __syncthreads();
        LAS float* scr = (LAS float*)(F.lds + 4096 + F.wave * 12288);
        const int gw = F.vcu * NWAVES + F.wave, NGW = F.G * NWAVES;
        for (int rep2_ = 0; rep2_ < (REP_PH == 50 ? 2 : 1); ++rep2_)
        for (int it = gw; it < 3 * 4096; it += NGW) { const int which = it >> 12, r = it & 4095;
            if (which < 2) { const int e = r >> 7, kb = (r >> 3) & 15, nb = r & 7;
                p0_transpose_item(args.in[27 + which] + (size_t)e * 1024 * 256, 1024, 256, WGU + (size_t)e * 512 * 1024, 1024, ((32 * nb) >> 7) * 128 + which * 128, scr, kb, nb, F_LANE); }
            else { const int e = r >> 7, kb = (r >> 5) & 3, nb = r & 31;
                p0_transpose_item(args.in[29] + (size_t)e * 256 * 1024, 256, 1024, WD + (size_t)e * 1024 * 256, 256, 0, scr, kb, nb, F_LANE); } }
    }
    SEAM(PH_ROUTER);
    for (int rep_ = 0; rep_ < (REP_PH == PH_MOE1 ? 2 : 1); ++rep_) if (IN(PH_MOE1)) {
        moe_tables(F, cnt);
        LAS const int* tab = (LAS const int*)(F.lds + TAB_OFF);
        { LAS unsigned* rtab = (LAS unsigned*)(F.lds + RT_OFF); const int NT = tab[32];
          for (int i = 0; i < 2; ++i) { const int L = i * F.G + (int)blockIdx.x; if (L >= NT * 2) break; int pm, pn; pg8::tile_order(L, NT, 2, pm, pn);
              int e = 0;
#pragma unroll 1
              for (int k = 1; k < 32; ++k) e += (pm >= tab[k]) ? 1 : 0;
              const int tidx = F_TID;
              if (tidx < 256) { const int pos = (pm - tab[e]) * 256 + tidx; const int ne = (int)__hip_atomic_load(cnt + e, __ATOMIC_RELAXED, __HIP_MEMORY_SCOPE_AGENT);
                  rtab[i * 256 + tidx] = (unsigned)(pos < ne ? LIST[e * 16384 + pos] : 0) * (unsigned)(D * 2); } }
          __syncthreads(); }
        pg8::Gemm g{D, D, D}; MoeOrder S{(const char*)H2, (const char*)WGU, tab, tab[32], 2, F.G, (int)blockIdx.x, (size_t)0, (size_t)512 * 1024 * 2, (size_t)256 * 1024 * 2, RT_OFF};
        EpiAct E{ACT};
        pg8::gemm_phase<EpiAct, MoeOrder, true, true>(F.lds, g, S, E);
    }
    SEAM(PH_MOE1);
    for (int rep_ = 0; rep_ < (REP_PH == PH_MOE2 ? 2 : 1); ++rep_) if (IN(PH_MOE2)) {
        moe_tables(F, cnt);
        LAS const int* tab = (LAS const int*)(F.lds + TAB_OFF);
        pg8::Gemm g{256, 256, 256}; MoeOrder S{(const char*)ACT, (const char*)WD, tab, tab[32], 4, F.G, (int)blockIdx.x, (size_t)256 * 256 * 2, (size_t)1024 * 256 * 2, (size_t)256 * 256 * 2, -1};
        EpiYE E{YE};
        pg8::gemm_phase<EpiYE, MoeOrder, true>(F.lds, g, S, E);
    }
    SEAM(PH_MOE2);
    if (IN(PH_FINAL)) {
        moe_tables(F, cnt);
        LAS const int* ftab = (LAS const int*)(F.lds + TAB_OFF);
        const int gw = F.vcu * NWAVES + F.wave, NGW = F.G * NWAVES; const float* fg = args.in[30];
        for (int rr_ = 0; rr_ < (REP_PH == 52 ? 2 : 1); ++rr_) { const bool live = (REP_PH != 52) || rr_ == 1 || __hip_atomic_load(ctl + 700, __ATOMIC_RELAXED, __HIP_MEMORY_SCOPE_AGENT) == 12345u;
        for (int m = gw; m < M; m += NGW) { const int2 se = SEL_E[m], sp = SEL_P[m]; const int2 rw = make_int2(ftab[se.x] * 256 + sp.x, ftab[se.y] * 256 + sp.y); const float2 sw = SEL_W[m];
            const u32x2* xr = (const u32x2*)(X1 + (size_t)m * D) + F_LANE; const u32x2* y1 = (const u32x2*)(YE + (size_t)rw.x * D) + F_LANE; const u32x2* y2 = (const u32x2*)(YE + (size_t)rw.y * D) + F_LANE;
            f32x4 v[4]; float sq = 0.f;
#pragma unroll
            for (int j = 0; j < 4; ++j) { const u32x2 xw = xr[64 * j]; const f32x4 xv = (f32x4){bflo(xw.x), bfhi(xw.x), bflo(xw.y), bfhi(xw.y)}; const u32x2 a = y1[64 * j], b = y2[64 * j];
                v[j].x = xv.x + sw.x * __uint_as_float(a.x << 16) + sw.y * __uint_as_float(b.x << 16);
                v[j].y = xv.y + sw.x * __uint_as_float(a.x & 0xffff0000u) + sw.y * __uint_as_float(b.x & 0xffff0000u);
                v[j].z = xv.z + sw.x * __uint_as_float(a.y << 16) + sw.y * __uint_as_float(b.y << 16);
                v[j].w = xv.w + sw.x * __uint_as_float(a.y & 0xffff0000u) + sw.y * __uint_as_float(b.y & 0xffff0000u);
                sq += (v[j].x * v[j].x + v[j].y * v[j].y) + (v[j].z * v[j].z + v[j].w * v[j].w); }
            const float rs = rsqrtf(wave_sum(sq) * (1.f / D) + 1e-6f);
            f32x4* o = (f32x4*)(args.out + (size_t)m * D) + F_LANE;
#pragma unroll
            for (int j = 0; j < 4; ++j) { const f32x4 gg = *((const f32x4*)fg + F_LANE + 64 * j); if (live) o[64 * j] = (f32x4){v[j].x * rs * gg.x, v[j].y * rs * gg.y, v[j].z * rs * gg.z, v[j].w * rs * gg.w}; }
        }
        }
    }
#undef IN
#undef SEAM
}
}

extern "C" void kernel_launch(void* const* d_in, const int* in_sizes, int n_in, void* d_out, int out_size, void* d_ws, size_t ws_size, hipStream_t stream) {
    char* ws = (char*)d_ws;
    static int grid = 0;
    if (grid == 0) {
        int dev = 0, cus = 0;
        if (hipGetDevice(&dev) != hipSuccess || hipDeviceGetAttribute(&cus, hipDeviceAttributeMultiprocessorCount, dev) != hipSuccess) { grid = -1; return; }
        if (hipFuncSetAttribute((const void*)mega, hipFuncAttributeMaxDynamicSharedMemorySize, LDS_BYTES) != hipSuccess) { grid = -1; return; }
        grid = cus;
    }
    if (grid < 0) return;
    (void)hipMemsetAsync(ws + WS_CTL, 0, CTL_ZERO_BYTES, stream);
    Args a{};
    for (int i = 0; i < 31; ++i) a.in[i] = (const float*)d_in[i];
    a.out = (float*)d_out; a.ws = (unsigned char*)d_ws;
    auto launch = [&](int lo, int hi, int li) { a.ph_lo = lo; a.ph_hi = hi; a.li = li; hipLaunchKernelGGL(mega, dim3(grid), dim3(NTHREADS), LDS_BYTES, stream, a); };
    launch(PH_P0, PH_END, 0);
}
```
